# Optimizing an MI355X kernel written in HIP

```python
import jax, jax.numpy as jnp
from jax import lax
import numpy as np

D_MODEL = 1024
BATCH = 8
SEQ = 2048
DEPTH = 4

MIX_WIDTH = D_MODEL
POOL_WIDTH = MIX_WIDTH // 2
POOL_WINDOWS = (2, 4, 8, 16)
N_POOL_GROUPS = len(POOL_WINDOWS)
POOL_GROUP = POOL_WIDTH // N_POOL_GROUPS
ATTN_WIDTH = MIX_WIDTH - POOL_WIDTH
HEAD_DIM = 64
N_HEADS = ATTN_WIDTH // HEAD_DIM
N_KV_HEADS = 2
GQA_GROUP = N_HEADS // N_KV_HEADS
WINDOW = 128
BLOCK = 128
Q_OFF = POOL_WIDTH
K_OFF = Q_OFF + N_HEADS * HEAD_DIM
V_OFF = K_OFF + N_KV_HEADS * HEAD_DIM
IN_WIDTH = V_OFF + N_KV_HEADS * HEAD_DIM

N_KEYS = 128
N_EXPERTS = N_KEYS * N_KEYS
PEER_HEADS = 8
PEER_TOPK = 16
D_KEY = 256
D_HALF = D_KEY // 2
PEER_CHUNK = 128

RMS_EPS = 1e-6
N_MOD = 6

kernel_name = "hybrid_pool_swa_peer_adaln_trunk"


def rms_norm(x, g):
    xf = x.astype(jnp.float32)
    y = xf * lax.rsqrt(jnp.mean(xf * xf, axis=-1, keepdims=True) + RMS_EPS)
    return (y * g.astype(jnp.float32)).astype(x.dtype)


def alibi_slopes(n_heads):
    return jnp.exp2(-8.0 * jnp.arange(1, n_heads + 1, dtype=jnp.float32) / n_heads)


def multiscale_pool(p, pool_w, pool_scale):
    B, S, _ = p.shape
    pg = p.reshape(B, S, N_POOL_GROUPS, POOL_GROUP)
    cs = jnp.cumsum(pg.astype(jnp.float32), axis=1)
    pos1 = jnp.arange(1, S + 1, dtype=jnp.float32)
    means = []
    for g, w in enumerate(POOL_WINDOWS):
        cg = cs[:, :, g]
        lag = jnp.pad(cg, ((0, 0), (w, 0), (0, 0)))[:, :S]
        means.append((cg - lag) / jnp.minimum(pos1, float(w))[None, :, None])
    pooled = jnp.stack(means, axis=2).astype(p.dtype) - pg
    mixed = jnp.einsum('bsgc,gcd->bsgd', pooled, pool_w)
    return mixed.reshape(B, S, POOL_WIDTH) * pool_scale


def band_blocks(t, nb):
    B = t.shape[0]
    tb = t.reshape(B, nb, BLOCK, N_KV_HEADS, HEAD_DIM)
    prev = jnp.pad(tb, ((0, 0), (1, 0), (0, 0), (0, 0), (0, 0)))[:, :nb]
    return jnp.concatenate([prev, tb], axis=2)


def sliding_window_attention(q, k, v, sinks):
    B, S = q.shape[:2]
    nb = S // BLOCK
    qb = q.reshape(B, nb, BLOCK, N_KV_HEADS, GQA_GROUP, HEAD_DIM)
    kb = band_blocks(k, nb)
    vb = band_blocks(v, nb)
    scores = jnp.einsum('bnqkgd,bnskd->bnkgqs', qb, kb,
                        preferred_element_type=jnp.float32) * (HEAD_DIM ** -0.5)
    qi = jnp.arange(BLOCK)[:, None]
    sj = jnp.arange(2 * BLOCK)[None, :]
    dist = qi + BLOCK - sj
    band_ok = (dist >= 0) & (dist < WINDOW)
    blk = jnp.arange(nb)[:, None, None]
    valid = band_ok[None] & ((blk > 0) | (sj[None] >= BLOCK))
    slopes = alibi_slopes(N_HEADS).reshape(N_KV_HEADS, GQA_GROUP)
    bias = -slopes[:, :, None, None] * dist.astype(jnp.float32)
    scores = jnp.where(valid[None, :, None, None], scores + bias[None, None], -jnp.inf)
    sink = sinks.astype(jnp.float32).reshape(N_KV_HEADS, GQA_GROUP)[None, None, :, :, None, None]
    sink = jnp.broadcast_to(sink, scores.shape[:-1] + (1,))
    probs = jax.nn.softmax(jnp.concatenate([scores, sink], axis=-1), axis=-1)[..., :-1]
    out = jnp.einsum('bnkgqs,bnskd->bnqkgd', probs.astype(v.dtype), vb)
    return out.reshape(B, S, N_HEADS * HEAD_DIM)


def peer_ffn(h, wq, subkeys, u, v):
    B, S, D = h.shape
    T = B * S
    hf = h.reshape(T, D)
    q = (hf @ wq).reshape(T, PEER_HEADS, 2, D_HALF)
    s = jnp.einsum('thpd,pnd->thpn', q, subkeys, preferred_element_type=jnp.float32)
    top_s, top_i = lax.top_k(s, PEER_TOPK)
    cand = top_s[:, :, 0, :, None] + top_s[:, :, 1, None, :]
    best_s, best_j = lax.top_k(cand.reshape(T, PEER_HEADS, PEER_TOPK * PEER_TOPK), PEER_TOPK)
    i1 = jnp.take_along_axis(top_i[:, :, 0], best_j // PEER_TOPK, axis=-1)
    i2 = jnp.take_along_axis(top_i[:, :, 1], best_j % PEER_TOPK, axis=-1)
    expert = (i1 * N_KEYS + i2).reshape(T, PEER_HEADS * PEER_TOPK)
    gate = jax.nn.softmax(best_s, axis=-1).reshape(T, PEER_HEADS * PEER_TOPK).astype(h.dtype)
    nc = T // PEER_CHUNK

    def expert_block(args):
        hc, ec, gc = args
        uc = jnp.take(u, ec, axis=0)
        a = jnp.einsum('cd,ced->ce', hc, uc)
        act = jax.nn.gelu(a, approximate=False) * gc
        vc = jnp.take(v, ec, axis=0)
        return jnp.einsum('ce,ced->cd', act, vc)

    out = lax.map(expert_block, (hf.reshape(nc, PEER_CHUNK, D),
                                 expert.reshape(nc, PEER_CHUNK, -1),
                                 gate.reshape(nc, PEER_CHUNK, -1)))
    return out.reshape(B, S, D)


def setup_inputs(seed: int = 0) -> dict:
    key = jax.random.key(seed)
    ks = jax.random.split(key, 20)
    f32 = jnp.float32
    nrm = lambda k, shape, s: jax.random.normal(k, shape, f32) * s
    return {
        "x": nrm(ks[0], (BATCH, SEQ, D_MODEL), 1.0),
        "c": nrm(ks[1], (BATCH, D_MODEL), 1.0),
        "w_ada": nrm(ks[2], (DEPTH, D_MODEL, N_MOD * D_MODEL), 0.5 * D_MODEL ** -0.5),
        "b_ada": nrm(ks[3], (DEPTH, N_MOD * D_MODEL), 0.02),
        "norm1_g": 1.0 + nrm(ks[4], (DEPTH, D_MODEL), 0.05),
        "norm2_g": 1.0 + nrm(ks[5], (DEPTH, D_MODEL), 0.05),
        "w_in": nrm(ks[6], (DEPTH, D_MODEL, IN_WIDTH), D_MODEL ** -0.5),
        "pool_w": nrm(ks[7], (DEPTH, N_POOL_GROUPS, POOL_GROUP, POOL_GROUP), POOL_GROUP ** -0.5),
        "pool_scale": 1.0 + nrm(ks[8], (DEPTH, POOL_WIDTH), 0.1),
        "q_norm_g": 1.0 + nrm(ks[9], (DEPTH, HEAD_DIM), 0.05),
        "k_norm_g": 1.0 + nrm(ks[10], (DEPTH, HEAD_DIM), 0.05),
        "attn_sinks": nrm(ks[11], (DEPTH, N_HEADS), 0.5),
        "mix_norm_g": 1.0 + nrm(ks[12], (DEPTH, MIX_WIDTH), 0.05),
        "w_out": nrm(ks[13], (DEPTH, MIX_WIDTH, D_MODEL), MIX_WIDTH ** -0.5),
        "peer_wq": nrm(ks[14], (DEPTH, D_MODEL, PEER_HEADS * D_KEY), D_MODEL ** -0.5),
        "peer_subkeys": nrm(ks[15], (DEPTH, 2, N_KEYS, D_HALF), D_HALF ** -0.5),
        "peer_u": nrm(ks[16], (DEPTH, N_EXPERTS, D_MODEL), D_MODEL ** -0.5),
        "peer_v": nrm(ks[17], (DEPTH, N_EXPERTS, D_MODEL), PEER_HEADS ** -0.5),
    }


def reference(x, c, w_ada, b_ada, norm1_g, norm2_g, w_in, pool_w, pool_scale, q_norm_g,
              k_norm_g, attn_sinks, mix_norm_g, w_out, peer_wq, peer_subkeys, peer_u, peer_v):
    B, S, D = x.shape
    cond = jax.nn.silu(c)
    for l in range(DEPTH):
        mod = (cond @ w_ada[l] + b_ada[l])[:, None, :]
        sh1, sc1, g1, sh2, sc2, g2 = jnp.split(mod, N_MOD, axis=-1)

        h = rms_norm(x, norm1_g[l]) * (1.0 + sc1) + sh1
        proj = h @ w_in[l]
        p = proj[..., :Q_OFF]
        q = proj[..., Q_OFF:K_OFF].reshape(B, S, N_HEADS, HEAD_DIM)
        k = proj[..., K_OFF:V_OFF].reshape(B, S, N_KV_HEADS, HEAD_DIM)
        v = proj[..., V_OFF:].reshape(B, S, N_KV_HEADS, HEAD_DIM)
        q = rms_norm(q, q_norm_g[l])
        k = rms_norm(k, k_norm_g[l])
        pool_out = multiscale_pool(p, pool_w[l], pool_scale[l])
        attn_out = sliding_window_attention(q, k, v, attn_sinks[l])
        y = jnp.concatenate([pool_out, attn_out], axis=-1).reshape(B, S, 2, MIX_WIDTH // 2)
        y = rms_norm(y, jnp.ones((MIX_WIDTH // 2,), jnp.float32)).reshape(B, S, MIX_WIDTH) * mix_norm_g[l]
        x = x + g1 * (y @ w_out[l])

        h2 = rms_norm(x, norm2_g[l]) * (1.0 + sc2) + sh2
        x = x + g2 * peer_ffn(h2, peer_wq[l], peer_subkeys[l], peer_u[l], peer_v[l])
    return x
```

```cpp
#include <hip/hip_runtime.h>
#include <hip/hip_bf16.h>
#include <cstdio>
#include <cstdint>
#include <cmath>
namespace pg8 {
#define PG8_LAS __attribute__((address_space(3)))
typedef unsigned short bf16_t;
typedef short bf16x8 __attribute__((ext_vector_type(8)));
typedef float f32x4 __attribute__((ext_vector_type(4)));
typedef unsigned u32x4 __attribute__((ext_vector_type(4)));
constexpr int BM = 256, BK = 64, HALF = 128, HTB = HALF * BK * 2  , STAGE_BYTES = 8 * HTB, NXCD = 8, WGM = 8;

__host__ __device__ __forceinline__ int lds_byte(int r, int c) { const int st = (r >> 4) * 2 + (c >> 5), rr = r & 15, cc = c & 31, ob = rr * 64 + cc * 2; return st * 1024 + (ob ^ (((ob >> 9) & 1) << 5)); }
__host__ __device__ __forceinline__ void stage_rc(int b, int& R, int& C) { const int st = b / 1024, sb = b % 1024, swz = sb ^ (((sb >> 9) & 1) << 5); R = (st >> 1) * 16 + swz / 64; C = (st & 1) * 32 + (swz % 64) / 2; }
__host__ __device__ __forceinline__ int perm32(int rho) { const int n = rho >> 4, i = rho & 15; return 8 * (i >> 2) + 4 * n + (i & 3); }

struct Unit { int pm, pn; };
struct Gemm { const bf16_t* A; const bf16_t* Bt; int M, N, K; };

struct StaticOrder {
    int nM, nN, nwg, G, c;
    __host__ __device__ void init(int M, int N, int G_, int c_) { nM = M / BM; nN = N / BM; nwg = nM * nN; G = G_; c = c_; }
    __host__ __device__ bool next(int i, Unit& u) const {
        const long L = (long)i * G + c; if (L >= nwg) return false;
        int wgid = (int)L; { const int q = nwg / NXCD, r = nwg % NXCD, xcd = wgid % NXCD, off = wgid / NXCD; wgid = (xcd < r ? xcd * (q + 1) : r * (q + 1) + (xcd - r) * q) + off; }
        const int nig = WGM * nN, gid = wgid / nig, fm = gid * WGM, gsz = (nM - fm) < WGM ? (nM - fm) : WGM;
        u.pm = fm + ((wgid % nig) % gsz); u.pn = (wgid % nig) / gsz; return true;
    }
    __device__ __forceinline__ void a_ready(const Unit&) const {}
    __device__ __forceinline__ void done(const Unit&) const {}
};

__device__ __forceinline__ unsigned cvt_pk_bf16(float lo, float hi) { unsigned r; asm volatile("v_cvt_pk_bf16_f32 %0, %1, %2" : "=v"(r) : "v"(lo), "v"(hi)); return r; }
typedef float f32x2 __attribute__((ext_vector_type(2)));
__device__ __forceinline__ f32x2 gelu_pk(f32x2 v) {
    const f32x2 av = __builtin_elementwise_abs(v), d = av * 0.2316418882f + 1.0f;
    f32x2 t; t.x = __builtin_amdgcn_rcpf(d.x); t.y = __builtin_amdgcn_rcpf(d.y);
    f32x2 q = t * 0.5307027145f + (-0.7265760135f); q = q * t + 0.7107068705f; q = q * t + (-0.142248368f); q = q * t + 0.127414796f; q = q * t;
    const f32x2 s = (v * v) * (-0.72134752044f);
    f32x2 e; e.x = __builtin_amdgcn_exp2f(s.x); e.y = __builtin_amdgcn_exp2f(s.y);
    const f32x2 m = v * (q * e), r = v - m;
    f32x2 o; o.x = v.x < 0.f ? m.x : r.x; o.y = v.y < 0.f ? m.y : r.y; return o;
}

template <int ACT  > struct EpiBf16 {
    static constexpr bool PERM = true, AFTER_DRAIN = false; static_assert(ACT == 0 || ACT == 1, "EpiBf16: ACT is 0 (none) or 1 (gelu_pk)");
    bf16_t* O; int ldc; const float* bias; int split_cols; size_t split_stride; float scale0;
    __device__ __forceinline__ void operator()(const f32x4 (&acc)[2][2][4][2], const Unit& u, int wr, int wc, int fr, int fq) const {
        const int row0 = u.pm * BM + wr * 64 + fr; int colt = u.pn * BM; bf16_t* base = O;
        float sc = 1.f; if (split_cols) { const int t = colt / split_cols; base += (size_t)t * split_stride; colt -= t * split_cols; if (t == 0) sc = scale0; }
        const int col0 = colt + wc * 32 + 8 * fq, bcol0 = u.pn * BM + wc * 32 + 8 * fq;
        f32x4 bv[2][2];
#pragma unroll
        for (int bj = 0; bj < 2; ++bj)
#pragma unroll
            for (int n = 0; n < 2; ++n) bv[bj][n] = bias ? *(const f32x4*)(bias + bcol0 + bj * HALF + 4 * n) : (f32x4){0.f, 0.f, 0.f, 0.f};
#pragma unroll
        for (int ai = 0; ai < 2; ++ai)
#pragma unroll
            for (int m = 0; m < 4; ++m) { bf16_t* rowp = base + (size_t)(row0 + ai * HALF + m * 16) * ldc + col0;
#pragma unroll
                for (int bj = 0; bj < 2; ++bj) { f32x4 v0 = acc[ai][bj][m][0] + bv[bj][0], v1 = acc[ai][bj][m][1] + bv[bj][1];
                    if (ACT == 1) { f32x2 a = gelu_pk((f32x2){v0[0], v0[1]}), b = gelu_pk((f32x2){v0[2], v0[3]}), c = gelu_pk((f32x2){v1[0], v1[1]}), d = gelu_pk((f32x2){v1[2], v1[3]});
                        v0 = (f32x4){a.x, a.y, b.x, b.y}; v1 = (f32x4){c.x, c.y, d.x, d.y}; }
                    v0 = v0 * sc; v1 = v1 * sc; u32x4 w; w.x = cvt_pk_bf16(v0[0], v0[1]); w.y = cvt_pk_bf16(v0[2], v0[3]); w.z = cvt_pk_bf16(v1[0], v1[1]); w.w = cvt_pk_bf16(v1[2], v1[3]);
                    *(u32x4*)(rowp + bj * HALF) = w; } }
    }
};
struct EpiRes {
    static constexpr bool PERM = false, AFTER_DRAIN = false;
    const float* xin; float* out; const float* gate;
    __device__ __forceinline__ void operator()(const f32x4 (&acc)[2][2][4][2], const Unit& u, int wr, int wc, int fr, int fq) const {
        const int row0 = u.pm * BM + wr * 64 + fr, col0 = u.pn * BM + wc * 32 + 4 * fq;
        const float* gp = gate + (size_t)(u.pm >> 3) * 6144 + col0;
        f32x4 gv[2][2];
#pragma unroll
        for (int bj = 0; bj < 2; ++bj)
#pragma unroll
            for (int n = 0; n < 2; ++n) gv[bj][n] = *(const f32x4*)(gp + bj * HALF + n * 16);
#pragma unroll
        for (int ai = 0; ai < 2; ++ai)
#pragma unroll
            for (int m = 0; m < 4; ++m) { const size_t off = (size_t)(row0 + ai * HALF + m * 16) * 1024 + col0;
#pragma unroll
                for (int bj = 0; bj < 2; ++bj)
#pragma unroll
                    for (int n = 0; n < 2; ++n) { const f32x4 xv = *(const f32x4*)(xin + off + bj * HALF + n * 16); *(f32x4*)(out + off + bj * HALF + n * 16) = xv + gv[bj][n] * acc[ai][bj][m][n]; } }
    }
};

template <class Epi, class Sched, bool ALIGN_EPI = false, bool SP2 = false>
__device__ __forceinline__ void gemm_phase(PG8_LAS unsigned char* lds, const Gemm g, const Sched& S, const Epi& E, const int tid) {
    const int wid = __builtin_amdgcn_readfirstlane(tid >> 6), lane = tid & 63, wr = wid >> 2, wc = wid & 3, fr = lane & 15, fq = lane >> 4;
    const int K = g.K, nt = K / BK;
    unsigned voffA[2], voffB[2];
#pragma unroll
    for (int i = 0; i < 2; ++i) { int R, C; stage_rc(tid * 16 + i * 8192, R, C); const int Rb = Epi::PERM ? ((R & ~31) + perm32(R & 31)) : R;
        voffA[i] = (unsigned)(R * K + C) * 2u; voffB[i] = (unsigned)(Rb * K + C) * 2u; }
    const size_t kstep = (size_t)(BK * 2);
    const size_t hstep = (size_t)HALF * K * 2;
    const size_t tstep = 2 * hstep;
    const unsigned ldsw = (unsigned)wid * 1024u;
    const int aoff = lds_byte(wr * 64 + fr, fq * 8), boff = lds_byte(wc * 32 + fr, fq * 8);
#define PG8_SA(b, h) (((b) * 2 + (h)) * HTB)
#define PG8_SB(b, h) ((4 + (b) * 2 + (h)) * HTB)
#define PG8_STAGE(bufoff, gbase, voff) do { _Pragma("unroll") for (int _i = 0; _i < 2; ++_i) \
        __builtin_amdgcn_global_load_lds((const unsigned*)((const char*)(gbase) + (voff)[_i]), (PG8_LAS unsigned*)(lds + (bufoff) + ldsw + _i * 8192), 16, 0, 0); } while (0)
#define PG8_LDA(dst, b, h) do { _Pragma("unroll") for (int m = 0; m < 4; ++m) _Pragma("unroll") for (int k = 0; k < 2; ++k) dst[m][k] = *(const PG8_LAS bf16x8*)(lds + PG8_SA(b, h) + aoff + m * 2048 + k * 1024); } while (0)
#define PG8_LDB(dst, b, h) do { _Pragma("unroll") for (int n = 0; n < 2; ++n) _Pragma("unroll") for (int k = 0; k < 2; ++k) dst[n][k] = *(const PG8_LAS bf16x8*)(lds + PG8_SB(b, h) + boff + n * 2048 + k * 1024); } while (0)
#define PG8_MMA(ai, bj, At, Bt) do { __builtin_amdgcn_s_setprio(1); _Pragma("unroll") for (int m = 0; m < 4; ++m) _Pragma("unroll") for (int n = 0; n < 2; ++n) _Pragma("unroll") for (int k = 0; k < 2; ++k) \
        acc[ai][bj][m][n] = __builtin_amdgcn_mfma_f32_16x16x32_bf16(Bt[n][k], At[m][k], acc[ai][bj][m][n], 0, 0, 0); __builtin_amdgcn_s_setprio(0); } while (0)
#define PG8_WAIT_V(n) asm volatile("s_waitcnt vmcnt(" #n ")" ::: "memory")
#define PG8_WAIT_L(n) asm volatile("s_waitcnt lgkmcnt(" #n ")" ::: "memory")
#define PG8_BAR __builtin_amdgcn_s_barrier()
#define PG8_SCHED __builtin_amdgcn_sched_barrier(0)
    Unit cur, nxt; int ui = 0;
    if (!S.next(0, cur)) return;
    f32x4 acc[2][2][4][2];
#pragma unroll
    for (int a = 0; a < 2; ++a)
#pragma unroll
        for (int b = 0; b < 2; ++b)
#pragma unroll
            for (int m = 0; m < 4; ++m)
#pragma unroll
                for (int n = 0; n < 2; ++n) acc[a][b][m][n] = (f32x4){0.f, 0.f, 0.f, 0.f};
    bf16x8 At[4][2], B0[2][2], B1[2][2];
    const char* cA = (const char*)g.A + (size_t)cur.pm * tstep; const char* cB = (const char*)g.Bt + (size_t)cur.pn * tstep;
    S.a_ready(cur);
    if constexpr (SP2) {
        PG8_STAGE(PG8_SB(0, 0), cB, voffB); PG8_STAGE(PG8_SB(0, 1), cB + hstep, voffB); PG8_STAGE(PG8_SA(0, 0), cA, voffA); PG8_STAGE(PG8_SA(0, 1), cA + hstep, voffA);
        if (wr == 1) PG8_BAR;
        PG8_WAIT_V(2); PG8_BAR;
        PG8_STAGE(PG8_SB(1, 0), cB + kstep, voffB); PG8_STAGE(PG8_SA(1, 0), cA + kstep, voffA); PG8_STAGE(PG8_SB(1, 1), cB + hstep + kstep, voffB);
        PG8_WAIT_V(6); PG8_BAR;
    } else {
        PG8_STAGE(PG8_SB(0, 0), cB, voffB); PG8_STAGE(PG8_SA(0, 0), cA, voffA); PG8_STAGE(PG8_SB(0, 1), cB + hstep, voffB); PG8_STAGE(PG8_SA(0, 1), cA + hstep, voffA);
        if (wr == 1) PG8_BAR;
        PG8_WAIT_V(4); PG8_BAR;
        PG8_STAGE(PG8_SB(1, 0), cB + kstep, voffB); PG8_STAGE(PG8_SA(1, 0), cA + kstep, voffA); PG8_STAGE(PG8_SB(1, 1), cB + hstep + kstep, voffB);
        PG8_WAIT_V(6); PG8_BAR;
    }
    for (;;) {
        const bool has_next = S.next(ui + 1, nxt);
        const char* nA = has_next ? (const char*)g.A + (size_t)nxt.pm * tstep : cA; const char* nB = has_next ? (const char*)g.Bt + (size_t)nxt.pn * tstep : cB;
        for (int t = 0; t < nt; t += 2) {
            const bool last = (t == nt - 2);
            const char* a1 = cA + (size_t)(t + 1) * kstep;
            const char* a2 = last ? nA : cA + (size_t)(t + 2) * kstep; const char* b2 = last ? nB : cB + (size_t)(t + 2) * kstep;
            const char* a3 = a2 + kstep; const char* b3 = b2 + kstep;
            if (last && has_next) S.a_ready(nxt);
            if constexpr (SP2) {
            PG8_LDB(B0, 0, 0); PG8_LDB(B1, 0, 1); PG8_SCHED; PG8_LDA(At, 0, 0); PG8_STAGE(PG8_SA(1, 1), a1 + hstep, voffA);
            PG8_WAIT_V(8); PG8_WAIT_L(0); PG8_BAR; PG8_MMA(0, 0, At, B0); PG8_MMA(0, 1, At, B1); PG8_BAR; PG8_SCHED;
            PG8_LDA(At, 0, 1); PG8_STAGE(PG8_SB(0, 0), b2, voffB); PG8_STAGE(PG8_SB(0, 1), b2 + hstep, voffB); PG8_STAGE(PG8_SA(0, 0), a2, voffA);
            PG8_WAIT_V(8); PG8_WAIT_L(0); PG8_BAR; PG8_MMA(1, 0, At, B0); PG8_MMA(1, 1, At, B1); PG8_BAR; PG8_SCHED;
            PG8_LDB(B0, 1, 0); PG8_LDB(B1, 1, 1); PG8_SCHED; PG8_LDA(At, 1, 0); PG8_STAGE(PG8_SA(0, 1), a2 + hstep, voffA);
            PG8_WAIT_V(8); PG8_WAIT_L(0); PG8_BAR; PG8_MMA(0, 0, At, B0); PG8_MMA(0, 1, At, B1); PG8_BAR; PG8_SCHED;
            PG8_LDA(At, 1, 1); PG8_STAGE(PG8_SB(1, 0), b3, voffB); PG8_STAGE(PG8_SB(1, 1), b3 + hstep, voffB); PG8_STAGE(PG8_SA(1, 0), a3, voffA);
            PG8_WAIT_V(8); PG8_WAIT_L(0); PG8_BAR; PG8_MMA(1, 0, At, B0); PG8_MMA(1, 1, At, B1); PG8_BAR; PG8_SCHED;
            } else {
            PG8_LDB(B0, 0, 0); PG8_SCHED; PG8_LDA(At, 0, 0); PG8_STAGE(PG8_SA(1, 1), a1 + hstep, voffA);
            PG8_WAIT_L(8); PG8_BAR; PG8_WAIT_L(0); PG8_MMA(0, 0, At, B0); PG8_BAR; PG8_SCHED;
            PG8_LDB(B1, 0, 1); PG8_STAGE(PG8_SB(0, 0), b2, voffB);
            PG8_BAR; PG8_WAIT_L(0); PG8_MMA(0, 1, At, B1); PG8_BAR;
            PG8_LDA(At, 0, 1); PG8_STAGE(PG8_SA(0, 0), a2, voffA);
            PG8_BAR; PG8_WAIT_L(0); PG8_MMA(1, 0, At, B0); PG8_BAR; PG8_SCHED;
            PG8_STAGE(PG8_SB(0, 1), b2 + hstep, voffB);
            PG8_WAIT_V(6); PG8_BAR; PG8_MMA(1, 1, At, B1); PG8_BAR;
            PG8_LDB(B0, 1, 0); PG8_SCHED; PG8_LDA(At, 1, 0); PG8_STAGE(PG8_SA(0, 1), a2 + hstep, voffA);
            PG8_WAIT_L(8); PG8_BAR; PG8_WAIT_L(0); PG8_MMA(0, 0, At, B0); PG8_BAR; PG8_SCHED;
            PG8_LDB(B1, 1, 1); PG8_STAGE(PG8_SB(1, 0), b3, voffB);
            PG8_BAR; PG8_WAIT_L(0); PG8_MMA(0, 1, At, B1); PG8_BAR;
            PG8_LDA(At, 1, 1); PG8_STAGE(PG8_SA(1, 0), a3, voffA);
            PG8_BAR; PG8_WAIT_L(0); PG8_MMA(1, 0, At, B0); PG8_BAR; PG8_SCHED;
            PG8_STAGE(PG8_SB(1, 1), b3 + hstep, voffB);
            PG8_WAIT_V(6); PG8_BAR; PG8_MMA(1, 1, At, B1); PG8_BAR;
            }
        }
        if constexpr (ALIGN_EPI) { if (wr == 0) PG8_BAR; }
        if constexpr (!Epi::AFTER_DRAIN) { E(acc, cur, wr, wc, fr, fq); S.done(cur); }
        if (!has_next) break;
#pragma unroll
        for (int a = 0; a < 2; ++a)
#pragma unroll
            for (int b = 0; b < 2; ++b)
#pragma unroll
                for (int m = 0; m < 4; ++m)
#pragma unroll
                    for (int n = 0; n < 2; ++n) acc[a][b][m][n] = (f32x4){0.f, 0.f, 0.f, 0.f};
        cur = nxt; cA = nA; cB = nB; ++ui;
        if constexpr (ALIGN_EPI) { if (wr == 1) PG8_BAR; }
    }
    PG8_WAIT_V(0);
    if constexpr (!ALIGN_EPI) { if (wr == 0) PG8_BAR; }
    PG8_BAR;
    if constexpr (Epi::AFTER_DRAIN) { E.fused(acc, cur, wr, wc, fr, fq, lds, wid, lane); S.done(cur); }
#undef PG8_SA
#undef PG8_SB
#undef PG8_STAGE
#undef PG8_LDA
#undef PG8_LDB
#undef PG8_MMA
#undef PG8_WAIT_V
#undef PG8_WAIT_L
#undef PG8_BAR
#undef PG8_SCHED
}
}

constexpr int NB = 8, SEQ = 2048, DM = 1024, T = NB * SEQ, DEPTH = 4;
constexpr int INW = 1280, NMOD = 6144, NEXP = 16384;
constexpr float RMS_EPS = 1e-6f, LOG2E = 1.4426950408889634f;
constexpr int NWAVES = 8;
constexpr int NPHASE = 2 + 6 * DEPTH;
#ifndef MK_PER_PHASE
#define MK_PER_PHASE 1
#endif

constexpr size_t MiB = 1u << 20;
constexpr size_t WS_CTL = 0, CTL_ZERO_BYTES = 1 * MiB;
constexpr size_t WS_MOD = 1 * MiB;
constexpr size_t WS_WIN = 2 * MiB;
constexpr size_t WS_WOUT = 12 * MiB;
constexpr size_t WS_WQ = 20 * MiB;
constexpr size_t WS_POOLW = 36 * MiB;
constexpr size_t WS_SUBK = 37 * MiB;
constexpr size_t WS_H = 38 * MiB;
constexpr size_t WS_PROJ = 70 * MiB;
constexpr size_t WS_Y = 110 * MiB;
constexpr size_t WS_QP = 142 * MiB;
constexpr size_t WS_UB = 206 * MiB;
constexpr size_t WS_VB = 334 * MiB;
constexpr size_t WS_END = 462 * MiB;
constexpr int CW_BAR = 4096;

constexpr int LDS_BYTES = 147456;
constexpr int MISC_OFF = 139264;

#define GAS __attribute__((address_space(1)))
#define LAS __attribute__((address_space(3)))
typedef unsigned short bf16;
typedef unsigned v4u __attribute__((ext_vector_type(4)));
typedef unsigned v2u __attribute__((ext_vector_type(2)));
typedef float f32x4 __attribute__((ext_vector_type(4)));
typedef float f32x16 __attribute__((ext_vector_type(16)));
typedef short bf16x8 __attribute__((ext_vector_type(8)));
typedef float f32x2_t __attribute__((ext_vector_type(2)));
typedef __bf16 bf16x2_t __attribute__((ext_vector_type(2)));
typedef GAS unsigned gu32;
#define RLX_AGENT __ATOMIC_RELAXED, __HIP_MEMORY_SCOPE_AGENT
#define LDS_WAIT() asm volatile("s_waitcnt lgkmcnt(0)" ::: "memory")
__device__ __forceinline__ unsigned pk2(float lo, float hi) { f32x2_t v = {lo, hi}; bf16x2_t b = __builtin_convertvector(v, bf16x2_t); return __builtin_bit_cast(unsigned, b); }
__device__ __forceinline__ float bflo(unsigned w) { return __uint_as_float(w << 16); }
__device__ __forceinline__ float bfhi(unsigned w) { return __uint_as_float(w & 0xffff0000u); }
__device__ __forceinline__ float dot2_bf16(unsigned w, unsigned x, float acc) { return __builtin_amdgcn_fdot2_f32_bf16(__builtin_bit_cast(bf16x2_t, w), __builtin_bit_cast(bf16x2_t, x), acc, false); }
__device__ __forceinline__ float wave_sum(float v) {
#pragma unroll
    for (int o = 1; o < 64; o <<= 1) v += __shfl_xor(v, o);
    return v;
}
__device__ __forceinline__ f32x16 mfma32(bf16x8 a, bf16x8 b, f32x16 c) { return __builtin_amdgcn_mfma_f32_32x32x16_bf16(a, b, c, 0, 0, 0); }
__device__ __forceinline__ f32x16 zero16() { f32x16 z;
#pragma unroll
    for (int i = 0; i < 16; ++i) z[i] = 0.f;
    return z; }
#define XB_TMO      128
#define XB_XCNT(j)  (256  + 64 * (j))
#define XB_XSUB(j)  (1280 + 64 * (j))
#define XB_XGEN(j)  (2304 + 64 * (j))
#define XB_TOP      3328
#define XB_TOPGEN   3392
#define XCD_BAR_WORDS 3456
#define XB_SPIN_CAP (1u << 18)

__device__ __forceinline__ unsigned xb_ld(unsigned* p)              { return __hip_atomic_load(p, __ATOMIC_RELAXED, __HIP_MEMORY_SCOPE_AGENT); }
__device__ __forceinline__ unsigned xb_add(unsigned* p, unsigned v) { return __hip_atomic_fetch_add(p, v, __ATOMIC_RELAXED, __HIP_MEMORY_SCOPE_AGENT); }
__device__ __forceinline__ unsigned xb_xcc_id() { return (unsigned)__builtin_amdgcn_s_getreg((3 << 11) | 20) & 0xFu; }
#define XB_SPIN(cond, bar) do { unsigned _sp = 0; while (cond) { __builtin_amdgcn_s_sleep(1); \
    if ((++_sp & 255u) == 0u) { if (xb_ld(&(bar)[XB_TMO])) break; if (_sp > XB_SPIN_CAP) { atomicAdd(&(bar)[XB_TMO], 1u); break; } } } } while (0)

struct XcdBarrier {
    unsigned* bar; unsigned x;
    volatile LAS unsigned* st;
};

__device__ __forceinline__ XcdBarrier xcd_barrier_post(unsigned* bar, volatile LAS unsigned* st) {
    XcdBarrier b; b.bar = bar; b.x = xb_xcc_id(); b.st = st;
    if (threadIdx.x == 0) (void)xb_add(&bar[XB_XCNT(b.x)], 1u);
    return b;
}
__device__ __forceinline__ void xcd_barrier_complete(unsigned* bar, unsigned x, unsigned& nloc, unsigned& nx) {
    const unsigned G = gridDim.x * gridDim.y * gridDim.z;
    unsigned sum, cnt, mine, sp = 0u;
    for (;;) {
        sum = 0u; cnt = 0u; mine = 0u;
#pragma unroll
        for (unsigned j = 0; j < 16; ++j) { const unsigned c = xb_ld(&bar[XB_XCNT(j)]); sum += c; cnt += (c > 0u) ? 1u : 0u; mine = (j == x) ? c : mine; }
        if (sum == G) break;
        __builtin_amdgcn_s_sleep(1);
        if ((++sp & 255u) == 0u) { if (xb_ld(&bar[XB_TMO])) break; if (sp > XB_SPIN_CAP) { atomicAdd(&bar[XB_TMO], 1u); break; } }
    }
    nloc = mine > 0u ? mine : 1u; nx = cnt > 0u ? cnt : 1u;
}

__device__ __forceinline__ void xcd_barrier(const XcdBarrier& b) {
    asm volatile("s_waitcnt vmcnt(0)" ::: "memory");
    __syncthreads();
    if (threadIdx.x == 0) {
        unsigned* bar = b.bar;
        __builtin_amdgcn_s_waitcnt(0);
        unsigned nloc = b.st[0], nx = b.st[1];
        if (nloc == 0u) { xcd_barrier_complete(bar, b.x, nloc, nx); b.st[0] = nloc; b.st[1] = nx; }
        const unsigned old = xb_add(&bar[XB_XSUB(b.x)], 1u);
        const unsigned gen = old / nloc;
        if (old + 1u == (gen + 1u) * nloc) {
            __builtin_amdgcn_fence(__ATOMIC_RELEASE, "agent");
            asm volatile("s_waitcnt vmcnt(0)" ::: "memory");
            const unsigned og = xb_add(&bar[XB_TOP], 1u);
            const unsigned tg = og / nx;
            if (og + 1u == (tg + 1u) * nx) xb_add(&bar[XB_TOPGEN], 1u);
            else XB_SPIN(xb_ld(&bar[XB_TOPGEN]) == tg, bar);
            __builtin_amdgcn_fence(__ATOMIC_ACQUIRE, "agent");
            xb_add(&bar[XB_XGEN(b.x)], 1u);
            asm volatile("s_waitcnt vmcnt(0)" ::: "memory");
        } else {
            XB_SPIN(xb_ld(&bar[XB_XGEN(b.x)]) == gen, bar);
            __builtin_amdgcn_fence(__ATOMIC_ACQUIRE, "agent");
            asm volatile("s_waitcnt vmcnt(0)" ::: "memory");
        }
    }
    __syncthreads();
}

__device__ __forceinline__ void phase_mod(LAS unsigned char* lds, const float* C, const float* w_ada, const float* b_ada, float* MOD, int tid, int bid, int G) {
    LAS float* cond = (LAS float*)lds; LAS float* part = (LAS float*)(lds + 32768);
    for (int i = tid; i < 8192; i += 512) { const int b = i >> 10, k = i & 1023; const float c = C[i]; cond[k * 8 + b] = c / (1.f + __expf(-c)); }
    __syncthreads();
    const int cg = tid & 31, ks = tid >> 5;
    for (int item = bid; item < 192; item += G) {
        const int col0 = item * 128, l = col0 / NMOD, n0 = col0 - l * NMOD;
        const float* W = w_ada + (size_t)l * DM * NMOD + n0 + cg * 4;
        f32x4 acc[8];
#pragma unroll
        for (int b = 0; b < 8; ++b) acc[b] = (f32x4){0.f, 0.f, 0.f, 0.f};
#pragma unroll 8
        for (int kk = 0; kk < 64; ++kk) {
            const int k = ks * 64 + kk;
            const f32x4 w = *(const f32x4*)(W + (size_t)k * NMOD);
            const f32x4 c0 = *(const LAS f32x4*)(cond + k * 8), c1 = *(const LAS f32x4*)(cond + k * 8 + 4);
#pragma unroll
            for (int b = 0; b < 4; ++b) { acc[b] += c0[b] * w; acc[4 + b] += c1[b] * w; }
        }
#pragma unroll
        for (int b = 0; b < 8; ++b) *(LAS f32x4*)(part + (ks * 8 + b) * 128 + cg * 4) = acc[b];
        __syncthreads();
        for (int o = tid; o < 1024; o += 512) {
            const int b = o >> 7, c = o & 127; float s = b_ada[l * NMOD + n0 + c];
#pragma unroll
            for (int k2 = 0; k2 < 16; ++k2) s += part[(k2 * 8 + b) * 128 + c];
            MOD[((size_t)l * 8 + b) * NMOD + n0 + c] = s;
        }
        __syncthreads();
    }
}
__device__ __forceinline__ void p0_transpose_item(const float* W, int K, int N, bf16* WT, LAS float* scr, int item, int lane) {
    const int nblk = N / 32, kb = item / nblk, nb = item % nblk, k0 = 64 * kb, n0 = 32 * nb;
#pragma unroll 8
    for (int i = 0; i < 32; ++i) { const int kk = 2 * i + (lane >> 5); scr[kk * 33 + (lane & 31)] = W[(size_t)(k0 + kk) * N + n0 + (lane & 31)]; }
    LDS_WAIT(); asm volatile("" ::: "memory");
    const int c = lane & 7;
#pragma unroll
    for (int j = 0; j < 4; ++j) { const int n = (lane >> 3) + 8 * j; const LAS float* s = scr + (8 * c) * 33 + n;
        v4u o; o.x = pk2(s[0 * 33], s[1 * 33]); o.y = pk2(s[2 * 33], s[3 * 33]); o.z = pk2(s[4 * 33], s[5 * 33]); o.w = pk2(s[6 * 33], s[7 * 33]);
        *(v4u*)(WT + (size_t)(n0 + n) * K + k0 + 8 * c) = o; }
    LDS_WAIT(); asm volatile("" ::: "memory");
}
__device__ __forceinline__ void cvt_stream(const float* src, bf16* dst, size_t n8, size_t gt, size_t GT) {
    for (size_t i = gt; i < n8; i += GT) {
        const f32x4 a = __builtin_nontemporal_load((const f32x4*)(src + i * 8)), b = __builtin_nontemporal_load((const f32x4*)(src + i * 8 + 4));
        v4u o; o.x = pk2(a.x, a.y); o.y = pk2(a.z, a.w); o.z = pk2(b.x, b.y); o.w = pk2(b.z, b.w);
        *(v4u*)(dst + i * 8) = o;
    }
}
__device__ __forceinline__ void norm_rows_phase(const float* X, const float* gvec, const float* modl, int sh_off, int sc_off, bf16* H, int gw, int NGW, int lane) {
    for (int m = gw; m < T; m += NGW) {
        const float* xr = X + (size_t)m * DM; const float* mb = modl + (size_t)(m >> 11) * NMOD;
        f32x4 v[4]; float s = 0.f;
#pragma unroll
        for (int j = 0; j < 4; ++j) { v[j] = *(const f32x4*)(xr + 256 * j + 4 * lane); s += (v[j].x * v[j].x + v[j].y * v[j].y) + (v[j].z * v[j].z + v[j].w * v[j].w); }
        const float rstd = rsqrtf(wave_sum(s) * (1.f / DM) + RMS_EPS);
#pragma unroll
        for (int j = 0; j < 4; ++j) { const int k = 256 * j + 4 * lane;
            const f32x4 g = *(const f32x4*)(gvec + k), sc = *(const f32x4*)(mb + sc_off + k), sh = *(const f32x4*)(mb + sh_off + k);
            const f32x4 o = v[j] * rstd * g * (1.f + sc) + sh;
            v2u w; w.x = pk2(o.x, o.y); w.y = pk2(o.z, o.w);
            *(v2u*)(H + (size_t)m * DM + k) = w; }
    }
}

constexpr int PL_STRIDE = 1040;
constexpr int KL_STRIDE = 144, KL_OFF = 0;
constexpr int VT_STRIDE = 392, VT_OFF = 55296;
constexpr int SSP_OFF = 106496, SSA_OFF = 108544;
__device__ __forceinline__ void unpack8(const v4u w, float (&f)[8]) {
    f[0] = bflo(w.x); f[1] = bfhi(w.x); f[2] = bflo(w.y); f[3] = bfhi(w.y); f[4] = bflo(w.z); f[5] = bfhi(w.z); f[6] = bflo(w.w); f[7] = bfhi(w.w); }
__device__ __forceinline__ v4u pack8(const float (&f)[8]) { v4u o; o.x = pk2(f[0], f[1]); o.y = pk2(f[2], f[3]); o.z = pk2(f[4], f[5]); o.w = pk2(f[6], f[7]); return o; }
__device__ __forceinline__ void phase_mix(LAS unsigned char* lds, const bf16* PROJ, const bf16* PWT, const float* pool_scale, const float* qg, const float* kg,
                                          const float* sinks, const float* mixg, bf16* Y, int tid, int vcu, int G) {
    const int lane = tid & 63, wave = __builtin_amdgcn_readfirstlane(tid >> 6), l31 = lane & 31, hi = lane >> 5;
    LAS float* SSP = (LAS float*)(lds + SSP_OFF); LAS float* SSA = (LAS float*)(lds + SSA_OFF);
    for (int u = vcu; u < 256; u += G) {
        const int b = u >> 5, t0 = (u & 31) * 64; const size_t row0 = (size_t)b * SEQ + t0;
        {
            const int g = wave >> 1, rh = wave & 1, ch = lane & 15, rs = lane >> 4, win = 2 << g, col = g * 128 + ch * 8;
            for (int i = 0; i < 8; ++i) {
                const int r = rh * 32 + i * 4 + rs, pos = t0 + r;
                const bf16* base = PROJ + ((size_t)b * SEQ + pos) * INW + col;
                float cur[8], sum[8], f[8];
                unpack8(*(const v4u*)base, cur);
#pragma unroll
                for (int k = 0; k < 8; ++k) sum[k] = cur[k];
                for (int j = 1; j < win; ++j) {
                    if (pos - j >= 0) { unpack8(*(const v4u*)(base - (size_t)j * INW), f);
#pragma unroll
                        for (int k = 0; k < 8; ++k) sum[k] += f[k]; }
                }
                const float inv = 1.f / (float)((pos + 1) < win ? (pos + 1) : win);
#pragma unroll
                for (int k = 0; k < 8; ++k) f[k] = sum[k] * inv - cur[k];
                *(LAS v4u*)(lds + r * PL_STRIDE + col * 2) = pack8(f);
            }
        }
        __syncthreads();
        f32x16 pacc[2][2];
        {
            const int g = wave >> 1, dh = wave & 1;
            const bf16* Wt = PWT + ((size_t)g * 128 + dh * 64) * 128;
#pragma unroll
            for (int a = 0; a < 2; ++a)
#pragma unroll
                for (int c = 0; c < 2; ++c) pacc[a][c] = zero16();
#pragma unroll
            for (int s = 0; s < 8; ++s) {
                bf16x8 af[2], bfr[2];
#pragma unroll
                for (int dt = 0; dt < 2; ++dt) af[dt] = *(const bf16x8*)(Wt + (size_t)(dt * 32 + l31) * 128 + s * 16 + hi * 8);
#pragma unroll
                for (int tt = 0; tt < 2; ++tt) bfr[tt] = *(const LAS bf16x8*)(lds + (tt * 32 + l31) * PL_STRIDE + (g * 128 + s * 16 + hi * 8) * 2);
#pragma unroll
                for (int tt = 0; tt < 2; ++tt)
#pragma unroll
                    for (int dt = 0; dt < 2; ++dt) pacc[tt][dt] = mfma32(af[dt], bfr[tt], pacc[tt][dt]);
            }
            const float* ps = pool_scale + g * 128 + dh * 64 + 4 * hi;
#pragma unroll
            for (int tt = 0; tt < 2; ++tt) {
                float ss = 0.f;
#pragma unroll
                for (int dt = 0; dt < 2; ++dt)
#pragma unroll
                    for (int i = 0; i < 4; ++i) { const f32x4 sc = *(const f32x4*)(ps + dt * 32 + 8 * i);
#pragma unroll
                        for (int e = 0; e < 4; ++e) { const float v = pacc[tt][dt][4 * i + e] * sc[e]; pacc[tt][dt][4 * i + e] = v; ss += v * v; } }
                ss += __shfl_xor(ss, 32);
                if (hi == 0) SSP[(tt * 32 + l31) * 8 + wave] = ss;
            }
        }
        __syncthreads();
        {
            const int cb = (wave >> 1) * 128 + (wave & 1) * 64 + 4 * hi;
#pragma unroll
            for (int tt = 0; tt < 2; ++tt) {
                const int tok = tt * 32 + l31;
                const f32x4 s0 = *(const LAS f32x4*)(SSP + tok * 8), s1 = *(const LAS f32x4*)(SSP + tok * 8 + 4);
                const float rp = rsqrtf(((s0.x + s0.y) + (s0.z + s0.w) + (s1.x + s1.y) + (s1.z + s1.w)) * (1.f / 512.f) + RMS_EPS);
                bf16* yrow = Y + (row0 + tok) * DM;
#pragma unroll
                for (int dt = 0; dt < 2; ++dt)
#pragma unroll
                    for (int i = 0; i < 4; ++i) { const int c = cb + dt * 32 + 8 * i; const f32x4 mg = *(const f32x4*)(mixg + c);
                        v2u w; w.x = pk2(pacc[tt][dt][4 * i] * rp * mg.x, pacc[tt][dt][4 * i + 1] * rp * mg.y); w.y = pk2(pacc[tt][dt][4 * i + 2] * rp * mg.z, pacc[tt][dt][4 * i + 3] * rp * mg.w);
                        *(v2u*)(yrow + c) = w; }
            }
        }
        {
#pragma unroll 2
            for (int i = 0; i < 6; ++i) {
                const int c = tid + 512 * i, kv = c / 1536, rem = c - kv * 1536, key = rem >> 3, part = rem & 7, kpos = t0 - 128 + key;
                v4u wk = (v4u){0u, 0u, 0u, 0u}, wv = (v4u){0u, 0u, 0u, 0u};
                if (kpos >= 0) { const bf16* src = PROJ + ((size_t)b * SEQ + kpos) * INW + 1024 + kv * 64 + part * 8; wk = *(const v4u*)src; wv = *(const v4u*)(src + 128); }
                float f[8]; unpack8(wk, f);
                float ss = 0.f;
#pragma unroll
                for (int k = 0; k < 8; ++k) ss += f[k] * f[k];
                ss += __shfl_xor(ss, 1); ss += __shfl_xor(ss, 2); ss += __shfl_xor(ss, 4);
                const float rstd = rsqrtf(ss * (1.f / 64.f) + RMS_EPS);
                const f32x4 g0 = *(const f32x4*)(kg + part * 8), g1 = *(const f32x4*)(kg + part * 8 + 4);
                f[0] *= rstd * g0.x; f[1] *= rstd * g0.y; f[2] *= rstd * g0.z; f[3] *= rstd * g0.w; f[4] *= rstd * g1.x; f[5] *= rstd * g1.y; f[6] *= rstd * g1.z; f[7] *= rstd * g1.w;
                *(LAS v4u*)(lds + KL_OFF + (kv * 192 + key) * KL_STRIDE + part * 16) = pack8(f);
                LAS unsigned short* vt = (LAS unsigned short*)(lds + VT_OFF + (kv * 64 + part * 8) * VT_STRIDE + key * 2);
                vt[0 * (VT_STRIDE / 2)] = (unsigned short)(wv.x & 0xffffu); vt[1 * (VT_STRIDE / 2)] = (unsigned short)(wv.x >> 16);
                vt[2 * (VT_STRIDE / 2)] = (unsigned short)(wv.y & 0xffffu); vt[3 * (VT_STRIDE / 2)] = (unsigned short)(wv.y >> 16);
                vt[4 * (VT_STRIDE / 2)] = (unsigned short)(wv.z & 0xffffu); vt[5 * (VT_STRIDE / 2)] = (unsigned short)(wv.z >> 16);
                vt[6 * (VT_STRIDE / 2)] = (unsigned short)(wv.w & 0xffffu); vt[7 * (VT_STRIDE / 2)] = (unsigned short)(wv.w >> 16);
            }
        }
        const int hh = wave, kvh = hh >> 2;
        bf16x8 qf[2][4];
#pragma unroll
        for (int qt = 0; qt < 2; ++qt) {
            const bf16* qp = PROJ + (row0 + qt * 32 + l31) * INW + 512 + hh * 64 + hi * 8;
            float f[4][8]; float ss = 0.f;
#pragma unroll
            for (int s = 0; s < 4; ++s) { unpack8(*(const v4u*)(qp + s * 16), f[s]);
#pragma unroll
                for (int k = 0; k < 8; ++k) ss += f[s][k] * f[s][k]; }
            ss += __shfl_xor(ss, 32);
            const float rstd = rsqrtf(ss * (1.f / 64.f) + RMS_EPS) * (0.125f * LOG2E);
#pragma unroll
            for (int s = 0; s < 4; ++s) { const f32x4 g0 = *(const f32x4*)(qg + s * 16 + hi * 8), g1 = *(const f32x4*)(qg + s * 16 + hi * 8 + 4);
                f[s][0] *= rstd * g0.x; f[s][1] *= rstd * g0.y; f[s][2] *= rstd * g0.z; f[s][3] *= rstd * g0.w; f[s][4] *= rstd * g1.x; f[s][5] *= rstd * g1.y; f[s][6] *= rstd * g1.z; f[s][7] *= rstd * g1.w;
                qf[qt][s] = __builtin_bit_cast(bf16x8, pack8(f[s])); }
        }
        __syncthreads();
        f32x16 o[2][2];
#pragma unroll
        for (int a = 0; a < 2; ++a)
#pragma unroll
            for (int c = 0; c < 2; ++c) o[a][c] = zero16();
        float lsum[2] = {0.f, 0.f};
        const float slope = exp2f(-(float)(hh + 1)) * LOG2E;
#pragma unroll
        for (int qt = 0; qt < 2; ++qt) {
#pragma unroll 1
            for (int kti = 0; kti < 5; ++kti) {
                const int kt = qt + kti;
                f32x16 sc = zero16();
#pragma unroll
                for (int s = 0; s < 4; ++s) { const bf16x8 kf = *(const LAS bf16x8*)(lds + KL_OFF + (kvh * 192 + kt * 32 + l31) * KL_STRIDE + (s * 16 + hi * 8) * 2); sc = mfma32(kf, qf[qt][s], sc); }
                const int qrel = 128 + qt * 32 + l31;
                float p[16]; float ls = 0.f;
#pragma unroll
                for (int r = 0; r < 16; ++r) { const int kk = kt * 32 + (r & 3) + 8 * (r >> 2) + 4 * hi, dist = qrel - kk;
                    const bool ok = (dist >= 0) && (dist < 128) && (t0 - 128 + kk >= 0);
                    const float arg = ok ? (sc[r] - slope * (float)dist) : -200.f;
                    p[r] = __builtin_amdgcn_exp2f(arg); ls += p[r]; }
                lsum[qt] += ls;
                bf16x8 pf[2];
#pragma unroll
                for (int s2 = 0; s2 < 2; ++s2) { v4u w; w.x = pk2(p[8 * s2], p[8 * s2 + 1]); w.y = pk2(p[8 * s2 + 2], p[8 * s2 + 3]); w.z = pk2(p[8 * s2 + 4], p[8 * s2 + 5]); w.w = pk2(p[8 * s2 + 6], p[8 * s2 + 7]); pf[s2] = __builtin_bit_cast(bf16x8, w); }
#pragma unroll
                for (int dt = 0; dt < 2; ++dt)
#pragma unroll
                    for (int s2 = 0; s2 < 2; ++s2) { const LAS unsigned char* ap = lds + VT_OFF + (kvh * 64 + dt * 32 + l31) * VT_STRIDE + (kt * 32 + s2 * 16 + hi * 4) * 2;
                        const v2u a0 = *(const LAS v2u*)ap, a1 = *(const LAS v2u*)(ap + 16); v4u av; av.x = a0.x; av.y = a0.y; av.z = a1.x; av.w = a1.y;
                        o[qt][dt] = mfma32(__builtin_bit_cast(bf16x8, av), pf[s2], o[qt][dt]); }
            }
        }
        const float sink = exp2f(sinks[hh] * LOG2E);
#pragma unroll
        for (int qt = 0; qt < 2; ++qt) {
            const float lt = lsum[qt] + __shfl_xor(lsum[qt], 32); const float inv = 1.f / (lt + sink); float ss = 0.f;
#pragma unroll
            for (int dt = 0; dt < 2; ++dt)
#pragma unroll
                for (int r = 0; r < 16; ++r) { const float v = o[qt][dt][r] * inv; o[qt][dt][r] = v; ss += v * v; }
            ss += __shfl_xor(ss, 32);
            if (hi == 0) SSA[(qt * 32 + l31) * 8 + hh] = ss;
        }
        __syncthreads();
        {
            const int cb = 512 + hh * 64 + 4 * hi;
#pragma unroll
            for (int tt = 0; tt < 2; ++tt) {
                const int tok = tt * 32 + l31;
                const f32x4 s0 = *(const LAS f32x4*)(SSA + tok * 8), s1 = *(const LAS f32x4*)(SSA + tok * 8 + 4);
                const float ra = rsqrtf(((s0.x + s0.y) + (s0.z + s0.w) + (s1.x + s1.y) + (s1.z + s1.w)) * (1.f / 512.f) + RMS_EPS);
                bf16* yrow = Y + (row0 + tok) * DM;
#pragma unroll
                for (int dt = 0; dt < 2; ++dt)
#pragma unroll
                    for (int i = 0; i < 4; ++i) { const int c = cb + dt * 32 + 8 * i; const f32x4 mg = *(const f32x4*)(mixg + c);
                        v2u w; w.x = pk2(o[tt][dt][4 * i] * ra * mg.x, o[tt][dt][4 * i + 1] * ra * mg.y); w.y = pk2(o[tt][dt][4 * i + 2] * ra * mg.z, o[tt][dt][4 * i + 3] * ra * mg.w);
                        *(v2u*)(yrow + c) = w; }
            }
        }
        __syncthreads();
    }
}

#ifndef PEER_PARTS
#define PEER_PARTS 3
#endif
constexpr int SK_STRIDE = 272, SK_OFF = 0;
constexpr int EI_OFF = 69632, EG_OFF = 102400;
#define CE_DESC(a, b) do { const float _h = fmaxf(a, b), _l = fminf(a, b); a = _h; b = _l; } while (0)
__device__ __forceinline__ void ins16(float (&L)[16], float x) {
#pragma unroll
    for (int i = 0; i < 16; ++i) CE_DESC(L[i], x);
}
__device__ __forceinline__ float clrbits(float v, unsigned m) { return __uint_as_float(__float_as_uint(v) & ~m); }
__device__ __forceinline__ void phase_peer(LAS unsigned char* lds, const bf16* QP, const bf16* SUBK, const bf16* UB, const bf16* VB, float* X, const float* modl, const float* n2g,
                                           const float* n1g_next, const float* mod_next, bf16* H, int tid, int bid, int G) {
    const int lane = tid & 63, wave = __builtin_amdgcn_readfirstlane(tid >> 6), l31 = lane & 31, hi = lane >> 5;
    LAS int* EI = (LAS int*)(lds + EI_OFF); LAS float* EG = (LAS float*)(lds + EG_OFF);
    for (int u = bid; u < 256; u += G) {
        const size_t row0 = (size_t)u * 64; const int b = u >> 5;
        for (int i = tid; i < 4096; i += 512) { const int row = i >> 4, ch = i & 15; *(LAS v4u*)(lds + SK_OFF + row * SK_STRIDE + ch * 16) = *(const v4u*)(SUBK + row * 128 + ch * 8); }
        __syncthreads();
#pragma unroll 1
        for (int tt = 0; tt < ((PEER_PARTS & 1) ? 2 : 0); ++tt) {
            float L[2][16];
#pragma unroll
            for (int p = 0; p < 2; ++p) {
                bf16x8 qf[8];
                const bf16* qp = QP + (row0 + tt * 32 + l31) * 2048 + wave * 256 + p * 128 + hi * 8;
#pragma unroll
                for (int s = 0; s < 8; ++s) qf[s] = *(const bf16x8*)(qp + s * 16);
                float Lp[16];
#pragma unroll
                for (int i = 0; i < 16; ++i) Lp[i] = -INFINITY;
#pragma unroll
                for (int np = 0; np < 2; ++np) {
                    f32x16 acc[2]; acc[0] = zero16(); acc[1] = zero16();
#pragma unroll
                    for (int s = 0; s < 8; ++s)
#pragma unroll
                        for (int n2 = 0; n2 < 2; ++n2) { const bf16x8 kf = *(const LAS bf16x8*)(lds + SK_OFF + (p * 128 + (np * 2 + n2) * 32 + l31) * SK_STRIDE + (s * 16 + hi * 8) * 2); acc[n2] = mfma32(kf, qf[s], acc[n2]); }
#pragma unroll
                    for (int n2 = 0; n2 < 2; ++n2)
#pragma unroll
                        for (int r = 0; r < 16; ++r)
                            ins16(Lp, __uint_as_float((__float_as_uint(acc[n2][r]) & ~127u) | (unsigned)((np * 2 + n2) * 16 + r)));
                }
#pragma unroll
                for (int i = 0; i < 16; ++i) Lp[i] = __uint_as_float(__float_as_uint(Lp[i]) | ((unsigned)hi << 6));
                float M[16];
#pragma unroll
                for (int i = 0; i < 16; ++i) M[i] = __shfl_xor(Lp[15 - i], 32);
#pragma unroll
                for (int i = 0; i < 16; ++i) M[i] = fmaxf(Lp[i], M[i]);
#pragma unroll
                for (int d = 8; d >= 1; d >>= 1)
#pragma unroll
                    for (int i = 0; i < 16; ++i) if ((i & d) == 0) CE_DESC(M[i], M[i + d]);
#pragma unroll
                for (int i = 0; i < 16; ++i) L[p][i] = M[i];
            }
            float Cc[16];
#pragma unroll
            for (int i = 0; i < 16; ++i) Cc[i] = -INFINITY;
            {
                int cidx = 0;
#pragma unroll
                for (int i = 0; i < 16; ++i)
#pragma unroll
                    for (int j = 0; j < 16; ++j) if ((i + 1) * (j + 1) <= 16) {
                        const float s = clrbits(L[0][i], 127u) + clrbits(L[1][j], 127u);
                        ins16(Cc, __uint_as_float((__float_as_uint(s) & ~127u) | (unsigned)cidx)); ++cidx; }
            }
            const float mx = clrbits(Cc[0], 127u); float ex[16]; float se = 0.f;
#pragma unroll
            for (int k = 0; k < 16; ++k) { ex[k] = __expf(clrbits(Cc[k], 127u) - mx); se += ex[k]; }
            const float inv = 1.f / se;
#pragma unroll
            for (int k = 0; k < 16; ++k) {
                const int c = (int)(__float_as_uint(Cc[k]) & 127u);
                const int ii = (c >= 16) + (c >= 24) + (c >= 29) + (c >= 33) + (c >= 36) + (c >= 38) + (c >= 40) + (c >= 42) + (c > 42 ? c - 42 : 0);
                const int st = ii == 0 ? 0 : ii == 1 ? 16 : ii == 2 ? 24 : ii == 3 ? 29 : ii == 4 ? 33 : ii == 5 ? 36 : ii == 6 ? 38 : ii == 7 ? 40 : 34 + ii;
                const int jj = c - st;
                unsigned t1 = 0u, t2 = 0u;
#pragma unroll
                for (int i = 0; i < 16; ++i) { t1 = (ii == i) ? __float_as_uint(L[0][i]) : t1; t2 = (jj == i) ? __float_as_uint(L[1][i]) : t2; }
                const unsigned n1 = ((t1 >> 4) & 3u) * 32u + (t1 & 3u) + 8u * ((t1 >> 2) & 3u) + 4u * ((t1 >> 6) & 1u);
                const unsigned n2 = ((t2 >> 4) & 3u) * 32u + (t2 & 3u) + 8u * ((t2 >> 2) & 3u) + 4u * ((t2 >> 6) & 1u);
                if (hi == 0) { EI[(tt * 32 + l31) * 128 + wave * 16 + k] = (int)(n1 * 128u + n2); EG[(tt * 32 + l31) * 128 + wave * 16 + k] = ex[k] * inv; }
            }
        }
        __syncthreads();
        const float* mb = modl + (size_t)b * NMOD;
#pragma unroll 1
        for (int ti = 0; ti < ((PEER_PARTS & 2) ? 8 : 0); ++ti) {
            const int tk = wave + 8 * ti; float* xr = X + (row0 + tk) * DM;
            f32x4 xa[4]; float ss = 0.f;
#pragma unroll
            for (int q = 0; q < 4; ++q) { xa[q] = *(const f32x4*)(xr + (q >> 1) * 512 + 8 * lane + 4 * (q & 1)); ss += (xa[q].x * xa[q].x + xa[q].y * xa[q].y) + (xa[q].z * xa[q].z + xa[q].w * xa[q].w); }
            const float rstd = rsqrtf(wave_sum(ss) * (1.f / DM) + RMS_EPS);
            unsigned hp[8];
#pragma unroll
            for (int q = 0; q < 4; ++q) { const int k = (q >> 1) * 512 + 8 * lane + 4 * (q & 1);
                const f32x4 g = *(const f32x4*)(n2g + k), sc = *(const f32x4*)(mb + 4096 + k), sh = *(const f32x4*)(mb + 3072 + k);
                const f32x4 h = xa[q] * rstd * g * (1.f + sc) + sh; hp[2 * q] = pk2(h.x, h.y); hp[2 * q + 1] = pk2(h.z, h.w); }
            const int e_lo = EI[tk * 128 + lane], e_hi = EI[tk * 128 + 64 + lane];
            float actb[8];
#pragma unroll
            for (int bt = 0; bt < 8; ++bt) {
                float pd[16];
#pragma unroll
                for (int k = 0; k < 16; ++k) { const int idx = bt * 16 + k; const int e = __builtin_amdgcn_readlane(idx < 64 ? e_lo : e_hi, idx & 63);
                    const v4u* up = (const v4u*)(UB + (size_t)e * DM) + lane; const v4u w0 = up[0], w1 = up[64];
                    float a0 = 0.f, a1 = 0.f; a0 = dot2_bf16(w0.x, hp[0], a0); a1 = dot2_bf16(w0.y, hp[1], a1); a0 = dot2_bf16(w0.z, hp[2], a0); a1 = dot2_bf16(w0.w, hp[3], a1);
                    a0 = dot2_bf16(w1.x, hp[4], a0); a1 = dot2_bf16(w1.y, hp[5], a1); a0 = dot2_bf16(w1.z, hp[6], a0); a1 = dot2_bf16(w1.w, hp[7], a1); pd[k] = a0 + a1; }
                float q8[8], q4[4], q2[2];
#pragma unroll
                for (int k = 0; k < 8; ++k) { const float snd = hi ? pd[k] : pd[k + 8], kp = hi ? pd[k + 8] : pd[k]; q8[k] = kp + __shfl_xor(snd, 32); }
                const int b4 = (lane >> 4) & 1, b3 = (lane >> 3) & 1, b2 = (lane >> 2) & 1;
#pragma unroll
                for (int k = 0; k < 4; ++k) { const float snd = b4 ? q8[k] : q8[k + 4], kp = b4 ? q8[k + 4] : q8[k]; q4[k] = kp + __shfl_xor(snd, 16); }
#pragma unroll
                for (int k = 0; k < 2; ++k) { const float snd = b3 ? q4[k] : q4[k + 2], kp = b3 ? q4[k + 2] : q4[k]; q2[k] = kp + __shfl_xor(snd, 8); }
                float a; { const float snd = b2 ? q2[0] : q2[1], kp = b2 ? q2[1] : q2[0]; a = kp + __shfl_xor(snd, 4); }
                a += __shfl_xor(a, 2); a += __shfl_xor(a, 1);
                const float gate = EG[tk * 128 + bt * 16 + (lane >> 2)];
                actb[bt] = 0.5f * a * (1.f + erff(a * 0.70710678118f)) * gate;
            }
            float out[16];
#pragma unroll
            for (int i = 0; i < 16; ++i) out[i] = 0.f;
#pragma unroll
            for (int bt = 0; bt < 8; ++bt)
#pragma unroll
                for (int k = 0; k < 16; ++k) { const int idx = bt * 16 + k; const int e = __builtin_amdgcn_readlane(idx < 64 ? e_lo : e_hi, idx & 63);
                    const float wgt = __uint_as_float(__builtin_amdgcn_readlane(__float_as_uint(actb[bt]), 4 * k));
                    const v4u* vp = (const v4u*)(VB + (size_t)e * DM) + lane; const v4u w0 = vp[0], w1 = vp[64];
                    out[0] += wgt * bflo(w0.x); out[1] += wgt * bfhi(w0.x); out[2] += wgt * bflo(w0.y); out[3] += wgt * bfhi(w0.y); out[4] += wgt * bflo(w0.z); out[5] += wgt * bfhi(w0.z); out[6] += wgt * bflo(w0.w); out[7] += wgt * bfhi(w0.w);
                    out[8] += wgt * bflo(w1.x); out[9] += wgt * bfhi(w1.x); out[10] += wgt * bflo(w1.y); out[11] += wgt * bfhi(w1.y); out[12] += wgt * bflo(w1.z); out[13] += wgt * bfhi(w1.z); out[14] += wgt * bflo(w1.w); out[15] += wgt * bfhi(w1.w); }
            float ss2 = 0.f;
#pragma unroll
            for (int q = 0; q < 4; ++q) { const int k = (q >> 1) * 512 + 8 * lane + 4 * (q & 1); const f32x4 g2 = *(const f32x4*)(mb + 5120 + k);
                f32x4 ov; ov.x = out[4 * q]; ov.y = out[4 * q + 1]; ov.z = out[4 * q + 2]; ov.w = out[4 * q + 3];
                xa[q] = xa[q] + g2 * ov; *(f32x4*)(xr + k) = xa[q]; ss2 += (xa[q].x * xa[q].x + xa[q].y * xa[q].y) + (xa[q].z * xa[q].z + xa[q].w * xa[q].w); }
            if (n1g_next) {
                const float rs2 = rsqrtf(wave_sum(ss2) * (1.f / DM) + RMS_EPS); const float* mn = mod_next + (size_t)b * NMOD; bf16* hr = H + (row0 + tk) * DM;
#pragma unroll
                for (int q = 0; q < 4; ++q) { const int k = (q >> 1) * 512 + 8 * lane + 4 * (q & 1);
                    const f32x4 g = *(const f32x4*)(n1g_next + k), sc = *(const f32x4*)(mn + 1024 + k), sh = *(const f32x4*)(mn + k);
                    const f32x4 h = xa[q] * rs2 * g * (1.f + sc) + sh; v2u w; w.x = pk2(h.x, h.y); w.y = pk2(h.z, h.w); *(v2u*)(hr + k) = w; }
            }
        }
        __syncthreads();
    }
}

#ifndef PH_MASK
#define PH_MASK 127
#endif
struct Args { const float* in[18]; float* out; unsigned char* ws; int ph_lo, ph_hi; };
__global__ void __launch_bounds__(NWAVES * 64, 2) trunk_fwd(Args args) {
    extern __shared__ __attribute__((aligned(16))) unsigned char lds_raw[];
    LAS unsigned char* lds = (LAS unsigned char*)lds_raw;
    const int tid0 = threadIdx.x;
    const int G = gridDim.x, bid0 = blockIdx.x;
    volatile LAS unsigned* MISC = (volatile LAS unsigned*)(lds + MISC_OFF);
    for (int u = tid0; u < (LDS_BYTES - MISC_OFF) / 4; u += NWAVES * 64) ((LAS unsigned*)(lds + MISC_OFF))[u] = 0u;
    __syncthreads();
    const int lo = args.ph_lo, hi_ph = args.ph_hi;
    XcdBarrier bar; bar.bar = (unsigned*)(args.ws + WS_CTL) + CW_BAR; bar.x = 0; bar.st = nullptr;
    if (hi_ph - lo > 1) bar = xcd_barrier_post((unsigned*)(args.ws + WS_CTL) + CW_BAR, MISC + 8);

    for (int ph = lo; ph < hi_ph; ++ph) {
        int tid = tid0; asm volatile("" : "+v"(tid));
        int bid = bid0; asm volatile("" : "+s"(bid));
        unsigned char* ws = args.ws; asm volatile("" : "+s"(ws));
        const int lane = tid & 63, wave = __builtin_amdgcn_readfirstlane(tid >> 6);
        const int vcu = (G % 8 == 0) ? (bid % 8) * (G / 8) + bid / 8 : bid;
        float* MOD = (float*)(ws + WS_MOD);
        bf16* WIN = (bf16*)(ws + WS_WIN); bf16* WOUT = (bf16*)(ws + WS_WOUT); bf16* WQ = (bf16*)(ws + WS_WQ); bf16* POOLW = (bf16*)(ws + WS_POOLW); bf16* SUBK = (bf16*)(ws + WS_SUBK);
        bf16* H = (bf16*)(ws + WS_H); bf16* PROJ = (bf16*)(ws + WS_PROJ); bf16* Y = (bf16*)(ws + WS_Y); bf16* QP = (bf16*)(ws + WS_QP);
        bf16* UB = (bf16*)(ws + WS_UB); bf16* VB = (bf16*)(ws + WS_VB);
        float* X = args.out;
        const int gw = vcu * NWAVES + wave, NGW = G * NWAVES;
        if (ph == 0 && (PH_MASK & 1)) {
            phase_mod(lds, args.in[1], args.in[2], args.in[3], MOD, tid, bid, G);
            LAS float* scr = (LAS float*)(lds + wave * 16384);
            constexpr int I_IN = 16 * 40, I_OUT = 16 * 32, I_WQ = 16 * 64, I_L = I_IN + I_OUT + I_WQ, I_POOL = 16 * 8;
            for (int it = gw; it < DEPTH * I_L + I_POOL; it += NGW) {
                if (it < DEPTH * I_L) {
                    const int l = it / I_L; int r = it - l * I_L;
                    if (r < I_IN) p0_transpose_item(args.in[6] + (size_t)l * DM * INW, DM, INW, WIN + (size_t)l * INW * DM, scr, r, lane);
                    else if (r < I_IN + I_OUT) p0_transpose_item(args.in[13] + (size_t)l * DM * DM, DM, DM, WOUT + (size_t)l * DM * DM, scr, r - I_IN, lane);
                    else p0_transpose_item(args.in[14] + (size_t)l * DM * 2048, DM, 2048, WQ + (size_t)l * 2048 * DM, scr, r - I_IN - I_OUT, lane);
                } else {
                    const int r = it - DEPTH * I_L, lg = r >> 3;
                    p0_transpose_item(args.in[7] + (size_t)lg * 128 * 128, 128, 128, POOLW + (size_t)lg * 128 * 128, scr, r & 7, lane);
                }
            }
            const size_t gt = (size_t)bid * 512 + tid, GT = (size_t)G * 512;
            cvt_stream(args.in[15], SUBK, (size_t)DEPTH * 2 * 128 * 128 / 8, gt, GT);
            cvt_stream(args.in[16], UB, (size_t)DEPTH * NEXP * DM / 8, gt, GT);
            cvt_stream(args.in[17], VB, (size_t)DEPTH * NEXP * DM / 8, gt, GT);
        } else if (ph == 1 && (PH_MASK & 2)) {
            norm_rows_phase(args.in[0], args.in[4], MOD, 0, 1024, H, gw, NGW, lane);
        } else {
            const int l = (ph - 2) / 6, sub = (ph - 2) - 6 * l;
            const float* modl = MOD + (size_t)l * 8 * NMOD;
            if ((sub == 0 || sub == 4) && (PH_MASK & 4)) {
                pg8::Gemm g; pg8::StaticOrder S; pg8::EpiBf16<0> E;
                if (sub == 0) { g = pg8::Gemm{H, WIN + (size_t)l * INW * DM, T, INW, DM}; E = pg8::EpiBf16<0>{PROJ, INW, nullptr, 0, 0, 1.f}; }
                else { g = pg8::Gemm{H, WQ + (size_t)l * 2048 * DM, T, 2048, DM}; E = pg8::EpiBf16<0>{QP, 2048, nullptr, 0, 0, 1.f}; }
                S.init(g.M, g.N, G, bid);
                pg8::gemm_phase<pg8::EpiBf16<0>, pg8::StaticOrder, true, true>(lds, g, S, E, tid);
            } else if (sub == 1 && (PH_MASK & 8)) {
                phase_mix(lds, PROJ, POOLW + (size_t)l * 4 * 128 * 128, args.in[8] + l * 512, args.in[9] + l * 64, args.in[10] + l * 64, args.in[11] + l * 8, args.in[12] + l * DM, Y, tid, vcu, G);
            } else if (sub == 2 && (PH_MASK & 16)) {
                pg8::Gemm g{Y, WOUT + (size_t)l * DM * DM, T, DM, DM}; pg8::StaticOrder S; S.init(T, DM, G, bid);
                pg8::EpiRes E{l == 0 ? args.in[0] : X, X, modl + 2048};
                pg8::gemm_phase<pg8::EpiRes, pg8::StaticOrder, true, true>(lds, g, S, E, tid);
            } else if (sub == 3 && (PH_MASK & 32)) {
                norm_rows_phase(X, args.in[5] + l * DM, modl, 3072, 4096, H, gw, NGW, lane);
            } else if (PH_MASK & 64) {
                phase_peer(lds, QP, SUBK + (size_t)l * 2 * 128 * 128, UB + (size_t)l * NEXP * DM, VB + (size_t)l * NEXP * DM, X, modl, args.in[5] + l * DM,
                           (l + 1 < DEPTH) ? args.in[4] + (l + 1) * DM : nullptr, MOD + (size_t)(l + 1 < DEPTH ? l + 1 : l) * 8 * NMOD, H, tid, bid, G);
            }
        }
        if (ph + 1 < hi_ph) xcd_barrier(bar);
    }
}

extern "C" void kernel_launch(void* const* d_in, const int* in_sizes, int n_in, void* d_out, int out_size, void* d_ws, size_t ws_size, hipStream_t stream) {
    static int grid = 0;
    if (grid == 0) {
        if (n_in != 18 || out_size != T * DM || ws_size < WS_END) { fprintf(stderr, "kernel_launch: unexpected shapes (n_in %d, out %d, ws %zu); nothing launched\n", n_in, out_size, ws_size); grid = -1; return; }
        int dev = 0, cus = 0, per_cu = 0;
        if (hipGetDevice(&dev) != hipSuccess || hipDeviceGetAttribute(&cus, hipDeviceAttributeMultiprocessorCount, dev) != hipSuccess) { fprintf(stderr, "kernel_launch: device query failed\n"); grid = -1; return; }
        if (hipFuncSetAttribute((const void*)trunk_fwd, hipFuncAttributeMaxDynamicSharedMemorySize, LDS_BYTES) != hipSuccess) { fprintf(stderr, "kernel_launch: hipFuncSetAttribute failed\n"); grid = -1; return; }
        if (hipOccupancyMaxActiveBlocksPerMultiprocessor(&per_cu, (const void*)trunk_fwd, NWAVES * 64, LDS_BYTES) != hipSuccess || per_cu < 1)
            fprintf(stderr, "kernel_launch: note: occupancy query reports %d workgroups per CU\n", per_cu);
        (void)hipGetLastError();
        grid = cus;
    }
    if (grid < 0) return;
    if (hipMemsetAsync((char*)d_ws + WS_CTL, 0, CTL_ZERO_BYTES, stream) != hipSuccess) { fprintf(stderr, "kernel_launch: memset failed\n"); return; }
    Args a{};
    for (int i = 0; i < 18; ++i) a.in[i] = (const float*)d_in[i];
    a.out = (float*)d_out; a.ws = (unsigned char*)d_ws;
#if MK_PER_PHASE
    for (int ph = 0; ph < NPHASE; ++ph) { a.ph_lo = ph; a.ph_hi = ph + 1; hipLaunchKernelGGL(trunk_fwd, dim3(grid), dim3(NWAVES * 64), LDS_BYTES, stream, a); }
#else
    a.ph_lo = 0; a.ph_hi = NPHASE;
    hipLaunchKernelGGL(trunk_fwd, dim3(grid), dim3(NWAVES * 64), LDS_BYTES, stream, a);
#endif
    const hipError_t le = hipPeekAtLastError();
    if (le != hipSuccess) fprintf(stderr, "kernel_launch: launch failed: %s\n", hipGetErrorName(le));
}
```

```cpp
#include <hip/hip_runtime.h>
#include <hip/hip_bf16.h>
#include <cstdio>
#include <cstdint>
#include <cmath>
namespace pg8 {
#define PG8_LAS __attribute__((address_space(3)))
typedef unsigned short bf16_t;
typedef short bf16x8 __attribute__((ext_vector_type(8)));
typedef float f32x4 __attribute__((ext_vector_type(4)));
typedef unsigned u32x4 __attribute__((ext_vector_type(4)));
constexpr int BM = 256, BK = 64, HALF = 128, HTB = HALF * BK * 2  , STAGE_BYTES = 8 * HTB, NXCD = 8, WGM = 8;

__host__ __device__ __forceinline__ int lds_byte(int r, int c) { const int st = (r >> 4) * 2 + (c >> 5), rr = r & 15, cc = c & 31, ob = rr * 64 + cc * 2; return st * 1024 + (ob ^ (((ob >> 9) & 1) << 5)); }
__host__ __device__ __forceinline__ void stage_rc(int b, int& R, int& C) { const int st = b / 1024, sb = b % 1024, swz = sb ^ (((sb >> 9) & 1) << 5); R = (st >> 1) * 16 + swz / 64; C = (st & 1) * 32 + (swz % 64) / 2; }
__host__ __device__ __forceinline__ int perm32(int rho) { const int n = rho >> 4, i = rho & 15; return 8 * (i >> 2) + 4 * n + (i & 3); }

struct Unit { int pm, pn; };
struct Gemm { const bf16_t* A; const bf16_t* Bt; int M, N, K; };

struct StaticOrder {
    int nM, nN, nwg, G, c;
    __host__ __device__ void init(int M, int N, int G_, int c_) { nM = M / BM; nN = N / BM; nwg = nM * nN; G = G_; c = c_; }
    __host__ __device__ bool next(int i, Unit& u) const {
        const long L = (long)i * G + c; if (L >= nwg) return false;
        int wgid = (int)L; { const int q = nwg / NXCD, r = nwg % NXCD, xcd = wgid % NXCD, off = wgid / NXCD; wgid = (xcd < r ? xcd * (q + 1) : r * (q + 1) + (xcd - r) * q) + off; }
        const int nig = WGM * nN, gid = wgid / nig, fm = gid * WGM, gsz = (nM - fm) < WGM ? (nM - fm) : WGM;
        u.pm = fm + ((wgid % nig) % gsz); u.pn = (wgid % nig) / gsz; return true;
    }
    __device__ __forceinline__ void a_ready(const Unit&) const {}
    __device__ __forceinline__ void done(const Unit&) const {}
};

__device__ __forceinline__ unsigned cvt_pk_bf16(float lo, float hi) { unsigned r; asm volatile("v_cvt_pk_bf16_f32 %0, %1, %2" : "=v"(r) : "v"(lo), "v"(hi)); return r; }
typedef float f32x2 __attribute__((ext_vector_type(2)));
__device__ __forceinline__ f32x2 gelu_pk(f32x2 v) {
    const f32x2 av = __builtin_elementwise_abs(v), d = av * 0.2316418882f + 1.0f;
    f32x2 t; t.x = __builtin_amdgcn_rcpf(d.x); t.y = __builtin_amdgcn_rcpf(d.y);
    f32x2 q = t * 0.5307027145f + (-0.7265760135f); q = q * t + 0.7107068705f; q = q * t + (-0.142248368f); q = q * t + 0.127414796f; q = q * t;
    const f32x2 s = (v * v) * (-0.72134752044f);
    f32x2 e; e.x = __builtin_amdgcn_exp2f(s.x); e.y = __builtin_amdgcn_exp2f(s.y);
    const f32x2 m = v * (q * e), r = v - m;
    f32x2 o; o.x = v.x < 0.f ? m.x : r.x; o.y = v.y < 0.f ? m.y : r.y; return o;
}

template <int ACT  > struct EpiBf16 {
    static constexpr bool PERM = true, AFTER_DRAIN = false; static_assert(ACT == 0 || ACT == 1, "EpiBf16: ACT is 0 (none) or 1 (gelu_pk)");
    bf16_t* O; int ldc; const float* bias; int split_cols; size_t split_stride; float scale0;
    __device__ __forceinline__ void operator()(const f32x4 (&acc)[2][2][4][2], const Unit& u, int wr, int wc, int fr, int fq) const {
        const int row0 = u.pm * BM + wr * 64 + fr; int colt = u.pn * BM; bf16_t* base = O;
        float sc = 1.f; if (split_cols) { const int t = colt / split_cols; base += (size_t)t * split_stride; colt -= t * split_cols; if (t == 0) sc = scale0; }
        const int col0 = colt + wc * 32 + 8 * fq, bcol0 = u.pn * BM + wc * 32 + 8 * fq;
        f32x4 bv[2][2];
#pragma unroll
        for (int bj = 0; bj < 2; ++bj)
#pragma unroll
            for (int n = 0; n < 2; ++n) bv[bj][n] = bias ? *(const f32x4*)(bias + bcol0 + bj * HALF + 4 * n) : (f32x4){0.f, 0.f, 0.f, 0.f};
#pragma unroll
        for (int ai = 0; ai < 2; ++ai)
#pragma unroll
            for (int m = 0; m < 4; ++m) { bf16_t* rowp = base + (size_t)(row0 + ai * HALF + m * 16) * ldc + col0;
#pragma unroll
                for (int bj = 0; bj < 2; ++bj) { f32x4 v0 = acc[ai][bj][m][0] + bv[bj][0], v1 = acc[ai][bj][m][1] + bv[bj][1];
                    if (ACT == 1) { f32x2 a = gelu_pk((f32x2){v0[0], v0[1]}), b = gelu_pk((f32x2){v0[2], v0[3]}), c = gelu_pk((f32x2){v1[0], v1[1]}), d = gelu_pk((f32x2){v1[2], v1[3]});
                        v0 = (f32x4){a.x, a.y, b.x, b.y}; v1 = (f32x4){c.x, c.y, d.x, d.y}; }
                    v0 = v0 * sc; v1 = v1 * sc; u32x4 w; w.x = cvt_pk_bf16(v0[0], v0[1]); w.y = cvt_pk_bf16(v0[2], v0[3]); w.z = cvt_pk_bf16(v1[0], v1[1]); w.w = cvt_pk_bf16(v1[2], v1[3]);
                    *(u32x4*)(rowp + bj * HALF) = w; } }
    }
};
struct EpiRes {
    static constexpr bool PERM = false, AFTER_DRAIN = false;
    const float* xin; float* out; const float* gate;
    __device__ __forceinline__ void operator()(const f32x4 (&acc)[2][2][4][2], const Unit& u, int wr, int wc, int fr, int fq) const {
        const int row0 = u.pm * BM + wr * 64 + fr, col0 = u.pn * BM + wc * 32 + 4 * fq;
        const float* gp = gate + (size_t)(u.pm >> 3) * 6144 + col0;
        f32x4 gv[2][2];
#pragma unroll
        for (int bj = 0; bj < 2; ++bj)
#pragma unroll
            for (int n = 0; n < 2; ++n) gv[bj][n] = *(const f32x4*)(gp + bj * HALF + n * 16);
#pragma unroll
        for (int ai = 0; ai < 2; ++ai)
#pragma unroll
            for (int m = 0; m < 4; ++m) { const size_t off = (size_t)(row0 + ai * HALF + m * 16) * 1024 + col0;
#pragma unroll
                for (int bj = 0; bj < 2; ++bj)
#pragma unroll
                    for (int n = 0; n < 2; ++n) { const f32x4 xv = *(const f32x4*)(xin + off + bj * HALF + n * 16); *(f32x4*)(out + off + bj * HALF + n * 16) = xv + gv[bj][n] * acc[ai][bj][m][n]; } }
    }
};


struct EpiRes2 {
    static constexpr bool PERM = false, AFTER_DRAIN = true;
    const float* xin; float* out; const float* gate; const float* gg2; bf16_t* xg; float* ss; float gscale;
    __device__ __forceinline__ void fused(f32x4 (&acc)[2][2][4][2], const Unit& u, int wr, int wc, int fr, int fq, PG8_LAS unsigned char* lds, int wid, int lane) const {
        constexpr int RS = 1040;
        const int b = u.pm >> 3, colg = u.pn * BM + 4 * lane;
        const f32x4 gv = *(const f32x4*)(gate + (size_t)b * 6144 + colg) * gscale, g2v = *(const f32x4*)(gg2 + (size_t)b * 1024 + colg);
#pragma unroll
        for (int ai = 0; ai < 2; ++ai) {
            if (ai) { asm volatile("s_waitcnt lgkmcnt(0)" ::: "memory"); __builtin_amdgcn_s_barrier(); asm volatile("" ::: "memory"); }
#pragma unroll
            for (int m = 0; m < 4; ++m)
#pragma unroll
                for (int bj = 0; bj < 2; ++bj)
#pragma unroll
                    for (int n = 0; n < 2; ++n) *(PG8_LAS f32x4*)(lds + (wr * 64 + m * 16 + fr) * RS + (bj * HALF + wc * 32 + n * 16 + fq * 4) * 4) = acc[ai][bj][m][n];
            asm volatile("s_waitcnt lgkmcnt(0)" ::: "memory"); __builtin_amdgcn_s_barrier(); asm volatile("" ::: "memory");
#pragma unroll
            for (int hq = 0; hq < 2; ++hq) {
                f32x4 xv[8];
#pragma unroll
                for (int i = 0; i < 8; ++i) { const int row = u.pm * BM + ai * HALF + wid * 16 + hq * 8 + i; xv[i] = *(const f32x4*)(xin + (size_t)row * 1024 + colg); }
#pragma unroll
                for (int i = 0; i < 8; ++i) { const int rl = wid * 16 + hq * 8 + i, row = u.pm * BM + ai * HALF + rl;
                    const f32x4 a = *(const PG8_LAS f32x4*)(lds + rl * RS + lane * 16);
                    const f32x4 x1 = xv[i] + gv * a;
                    *(f32x4*)(out + (size_t)row * 1024 + colg) = x1;
                    float s = (x1[0] * x1[0] + x1[1] * x1[1]) + (x1[2] * x1[2] + x1[3] * x1[3]);
                    const f32x4 gx = x1 * g2v; typedef unsigned u32x2 __attribute__((ext_vector_type(2))); u32x2 w; w.x = cvt_pk_bf16(gx[0], gx[1]); w.y = cvt_pk_bf16(gx[2], gx[3]);
                    *(u32x2*)(xg + (size_t)row * 1024 + colg) = w;
                    s += __int_as_float(__builtin_amdgcn_update_dpp(0, __float_as_int(s), 0xB1, 0xf, 0xf, true)); s += __int_as_float(__builtin_amdgcn_update_dpp(0, __float_as_int(s), 0x4E, 0xf, 0xf, true));
                    s += __int_as_float(__builtin_amdgcn_update_dpp(0, __float_as_int(s), 0x141, 0xf, 0xf, true)); s += __int_as_float(__builtin_amdgcn_update_dpp(0, __float_as_int(s), 0x140, 0xf, 0xf, true));
                    { auto r = __builtin_amdgcn_permlane16_swap(__float_as_uint(s), __float_as_uint(s), false, false); s = __uint_as_float(r[0]) + __uint_as_float(r[1]); }
                    { auto r = __builtin_amdgcn_permlane32_swap(__float_as_uint(s), __float_as_uint(s), false, false); s = __uint_as_float(r[0]) + __uint_as_float(r[1]); }
                    if (lane == 0) ss[(size_t)row * 4 + u.pn] = s; }
            }
        }
    }
};
struct EpiBf16RS {
    static constexpr bool PERM = true, AFTER_DRAIN = false;
    bf16_t* O; int ldc; const float* ss; const float* shq;
    __device__ __forceinline__ void operator()(const f32x4 (&acc)[2][2][4][2], const Unit& u, int wr, int wc, int fr, int fq) const {
        const int row0 = u.pm * BM + wr * 64 + fr, col0 = u.pn * BM + wc * 32 + 8 * fq, b = u.pm >> 3;
        const float* bp = shq + (size_t)b * ldc + col0;
        f32x4 bv[2][2];
#pragma unroll
        for (int bj = 0; bj < 2; ++bj)
#pragma unroll
            for (int n = 0; n < 2; ++n) bv[bj][n] = *(const f32x4*)(bp + bj * HALF + 4 * n);
        f32x4 sp[2][4];
#pragma unroll
        for (int ai = 0; ai < 2; ++ai)
#pragma unroll
            for (int m = 0; m < 4; ++m) sp[ai][m] = *(const f32x4*)(ss + (size_t)(row0 + ai * HALF + m * 16) * 4);
#pragma unroll
        for (int ai = 0; ai < 2; ++ai)
#pragma unroll
            for (int m = 0; m < 4; ++m) { const int row = row0 + ai * HALF + m * 16;
                const float rstd = __builtin_amdgcn_rsqf(((sp[ai][m][0] + sp[ai][m][1]) + (sp[ai][m][2] + sp[ai][m][3])) * (1.0f / 1024.0f) + 1e-6f);
                bf16_t* rowp = O + ((size_t)u.pm * (ldc / BM) + u.pn) * (BM * BM) + (size_t)((ai * 4 + m) * 2) * 4096 + ((wr * 4 + wc) * 64 + fq * 16 + fr) * 8; (void)row; (void)col0;
#pragma unroll
                for (int bj = 0; bj < 2; ++bj) { const f32x4 v0 = acc[ai][bj][m][0] * rstd + bv[bj][0], v1 = acc[ai][bj][m][1] * rstd + bv[bj][1];
                    u32x4 w; w.x = cvt_pk_bf16(v0[0], v0[1]); w.y = cvt_pk_bf16(v0[2], v0[3]); w.z = cvt_pk_bf16(v1[0], v1[1]); w.w = cvt_pk_bf16(v1[2], v1[3]);
                    *(u32x4*)(rowp + bj * 4096) = w; } }
    }
};
template <class Epi, class Sched, bool ALIGN_EPI = false, bool SP2 = false>
__device__ __forceinline__ void gemm_phase(PG8_LAS unsigned char* lds, const Gemm g, const Sched& S, const Epi& E, const int tid) {
    const int wid = __builtin_amdgcn_readfirstlane(tid >> 6), lane = tid & 63, wr = wid >> 2, wc = wid & 3, fr = lane & 15, fq = lane >> 4;
    const int K = g.K, nt = K / BK;
    unsigned voffA[2], voffB[2];
#pragma unroll
    for (int i = 0; i < 2; ++i) { int R, C; stage_rc(tid * 16 + i * 8192, R, C); const int Rb = Epi::PERM ? ((R & ~31) + perm32(R & 31)) : R;
        voffA[i] = (unsigned)(R * K + C) * 2u; voffB[i] = (unsigned)(Rb * K + C) * 2u; }
    const size_t kstep = (size_t)(BK * 2);
    const size_t hstep = (size_t)HALF * K * 2;
    const size_t tstep = 2 * hstep;
    const unsigned ldsw = (unsigned)wid * 1024u;
    const int aoff = lds_byte(wr * 64 + fr, fq * 8), boff = lds_byte(wc * 32 + fr, fq * 8);
#define PG8_SA(b, h) (((b) * 2 + (h)) * HTB)
#define PG8_SB(b, h) ((4 + (b) * 2 + (h)) * HTB)
#define PG8_STAGE(bufoff, gbase, voff) do { _Pragma("unroll") for (int _i = 0; _i < 2; ++_i) \
        __builtin_amdgcn_global_load_lds((const unsigned*)((const char*)(gbase) + (voff)[_i]), (PG8_LAS unsigned*)(lds + (bufoff) + ldsw + _i * 8192), 16, 0, 0); } while (0)
#define PG8_LDA(dst, b, h) do { _Pragma("unroll") for (int m = 0; m < 4; ++m) _Pragma("unroll") for (int k = 0; k < 2; ++k) dst[m][k] = *(const PG8_LAS bf16x8*)(lds + PG8_SA(b, h) + aoff + m * 2048 + k * 1024); } while (0)
#define PG8_LDB(dst, b, h) do { _Pragma("unroll") for (int n = 0; n < 2; ++n) _Pragma("unroll") for (int k = 0; k < 2; ++k) dst[n][k] = *(const PG8_LAS bf16x8*)(lds + PG8_SB(b, h) + boff + n * 2048 + k * 1024); } while (0)
#define PG8_MMA(ai, bj, At, Bt) do { __builtin_amdgcn_s_setprio(1); _Pragma("unroll") for (int m = 0; m < 4; ++m) _Pragma("unroll") for (int n = 0; n < 2; ++n) _Pragma("unroll") for (int k = 0; k < 2; ++k) \
        acc[ai][bj][m][n] = __builtin_amdgcn_mfma_f32_16x16x32_bf16(Bt[n][k], At[m][k], acc[ai][bj][m][n], 0, 0, 0); __builtin_amdgcn_s_setprio(0); } while (0)
#define PG8_WAIT_V(n) asm volatile("s_waitcnt vmcnt(" #n ")" ::: "memory")
#define PG8_WAIT_L(n) asm volatile("s_waitcnt lgkmcnt(" #n ")" ::: "memory")
#define PG8_BAR __builtin_amdgcn_s_barrier()
#define PG8_SCHED __builtin_amdgcn_sched_barrier(0)
    Unit cur, nxt; int ui = 0;
    if (!S.next(0, cur)) return;
    f32x4 acc[2][2][4][2];
#pragma unroll
    for (int a = 0; a < 2; ++a)
#pragma unroll
        for (int b = 0; b < 2; ++b)
#pragma unroll
            for (int m = 0; m < 4; ++m)
#pragma unroll
                for (int n = 0; n < 2; ++n) acc[a][b][m][n] = (f32x4){0.f, 0.f, 0.f, 0.f};
    bf16x8 At[4][2], B0[2][2], B1[2][2];
    const char* cA = (const char*)g.A + (size_t)cur.pm * tstep; const char* cB = (const char*)g.Bt + (size_t)cur.pn * tstep;
    S.a_ready(cur);
    if constexpr (SP2) {
        PG8_STAGE(PG8_SB(0, 0), cB, voffB); PG8_STAGE(PG8_SB(0, 1), cB + hstep, voffB); PG8_STAGE(PG8_SA(0, 0), cA, voffA); PG8_STAGE(PG8_SA(0, 1), cA + hstep, voffA);
        if (wr == 1) PG8_BAR;
        PG8_WAIT_V(2); PG8_BAR;
        PG8_STAGE(PG8_SB(1, 0), cB + kstep, voffB); PG8_STAGE(PG8_SA(1, 0), cA + kstep, voffA); PG8_STAGE(PG8_SB(1, 1), cB + hstep + kstep, voffB);
        PG8_WAIT_V(6); PG8_BAR;
    } else {
        PG8_STAGE(PG8_SB(0, 0), cB, voffB); PG8_STAGE(PG8_SA(0, 0), cA, voffA); PG8_STAGE(PG8_SB(0, 1), cB + hstep, voffB); PG8_STAGE(PG8_SA(0, 1), cA + hstep, voffA);
        if (wr == 1) PG8_BAR;
        PG8_WAIT_V(4); PG8_BAR;
        PG8_STAGE(PG8_SB(1, 0), cB + kstep, voffB); PG8_STAGE(PG8_SA(1, 0), cA + kstep, voffA); PG8_STAGE(PG8_SB(1, 1), cB + hstep + kstep, voffB);
        PG8_WAIT_V(6); PG8_BAR;
    }
    for (;;) {
        const bool has_next = S.next(ui + 1, nxt);
        const char* nA = has_next ? (const char*)g.A + (size_t)nxt.pm * tstep : cA; const char* nB = has_next ? (const char*)g.Bt + (size_t)nxt.pn * tstep : cB;
        for (int t = 0; t < nt; t += 2) {
            const bool last = (t == nt - 2);
            const char* a1 = cA + (size_t)(t + 1) * kstep;
            const char* a2 = last ? nA : cA + (size_t)(t + 2) * kstep; const char* b2 = last ? nB : cB + (size_t)(t + 2) * kstep;
            const char* a3 = a2 + kstep; const char* b3 = b2 + kstep;
            if (last && has_next) S.a_ready(nxt);
            if constexpr (SP2) {
            PG8_LDB(B0, 0, 0); PG8_LDB(B1, 0, 1); PG8_SCHED; PG8_LDA(At, 0, 0); PG8_STAGE(PG8_SA(1, 1), a1 + hstep, voffA);
            PG8_WAIT_V(8); PG8_WAIT_L(0); PG8_BAR; PG8_MMA(0, 0, At, B0); PG8_MMA(0, 1, At, B1); PG8_BAR; PG8_SCHED;
            PG8_LDA(At, 0, 1); PG8_STAGE(PG8_SB(0, 0), b2, voffB); PG8_STAGE(PG8_SB(0, 1), b2 + hstep, voffB); PG8_STAGE(PG8_SA(0, 0), a2, voffA);
            PG8_WAIT_V(8); PG8_WAIT_L(0); PG8_BAR; PG8_MMA(1, 0, At, B0); PG8_MMA(1, 1, At, B1); PG8_BAR; PG8_SCHED;
            PG8_LDB(B0, 1, 0); PG8_LDB(B1, 1, 1); PG8_SCHED; PG8_LDA(At, 1, 0); PG8_STAGE(PG8_SA(0, 1), a2 + hstep, voffA);
            PG8_WAIT_V(8); PG8_WAIT_L(0); PG8_BAR; PG8_MMA(0, 0, At, B0); PG8_MMA(0, 1, At, B1); PG8_BAR; PG8_SCHED;
            PG8_LDA(At, 1, 1); PG8_STAGE(PG8_SB(1, 0), b3, voffB); PG8_STAGE(PG8_SB(1, 1), b3 + hstep, voffB); PG8_STAGE(PG8_SA(1, 0), a3, voffA);
            PG8_WAIT_V(8); PG8_WAIT_L(0); PG8_BAR; PG8_MMA(1, 0, At, B0); PG8_MMA(1, 1, At, B1); PG8_BAR; PG8_SCHED;
            } else {
            PG8_LDB(B0, 0, 0); PG8_SCHED; PG8_LDA(At, 0, 0); PG8_STAGE(PG8_SA(1, 1), a1 + hstep, voffA);
            PG8_WAIT_L(8); PG8_BAR; PG8_WAIT_L(0); PG8_MMA(0, 0, At, B0); PG8_BAR; PG8_SCHED;
            PG8_LDB(B1, 0, 1); PG8_STAGE(PG8_SB(0, 0), b2, voffB);
            PG8_BAR; PG8_WAIT_L(0); PG8_MMA(0, 1, At, B1); PG8_BAR;
            PG8_LDA(At, 0, 1); PG8_STAGE(PG8_SA(0, 0), a2, voffA);
            PG8_BAR; PG8_WAIT_L(0); PG8_MMA(1, 0, At, B0); PG8_BAR; PG8_SCHED;
            PG8_STAGE(PG8_SB(0, 1), b2 + hstep, voffB);
            PG8_WAIT_V(6); PG8_BAR; PG8_MMA(1, 1, At, B1); PG8_BAR;
            PG8_LDB(B0, 1, 0); PG8_SCHED; PG8_LDA(At, 1, 0); PG8_STAGE(PG8_SA(0, 1), a2 + hstep, voffA);
            PG8_WAIT_L(8); PG8_BAR; PG8_WAIT_L(0); PG8_MMA(0, 0, At, B0); PG8_BAR; PG8_SCHED;
            PG8_LDB(B1, 1, 1); PG8_STAGE(PG8_SB(1, 0), b3, voffB);
            PG8_BAR; PG8_WAIT_L(0); PG8_MMA(0, 1, At, B1); PG8_BAR;
            PG8_LDA(At, 1, 1); PG8_STAGE(PG8_SA(1, 0), a3, voffA);
            PG8_BAR; PG8_WAIT_L(0); PG8_MMA(1, 0, At, B0); PG8_BAR; PG8_SCHED;
            PG8_STAGE(PG8_SB(1, 1), b3 + hstep, voffB);
            PG8_WAIT_V(6); PG8_BAR; PG8_MMA(1, 1, At, B1); PG8_BAR;
            }
        }
        if constexpr (ALIGN_EPI) { if (wr == 0) PG8_BAR; }
        if constexpr (!Epi::AFTER_DRAIN) { E(acc, cur, wr, wc, fr, fq); S.done(cur); }
        if (!has_next) break;
#pragma unroll
        for (int a = 0; a < 2; ++a)
#pragma unroll
            for (int b = 0; b < 2; ++b)
#pragma unroll
                for (int m = 0; m < 4; ++m)
#pragma unroll
                    for (int n = 0; n < 2; ++n) acc[a][b][m][n] = (f32x4){0.f, 0.f, 0.f, 0.f};
        cur = nxt; cA = nA; cB = nB; ++ui;
        if constexpr (ALIGN_EPI) { if (wr == 1) PG8_BAR; }
    }
    PG8_WAIT_V(0);
    if constexpr (!ALIGN_EPI) { if (wr == 0) PG8_BAR; }
    PG8_BAR;
    if constexpr (Epi::AFTER_DRAIN) { E.fused(acc, cur, wr, wc, fr, fq, lds, wid, lane); S.done(cur); }
#undef PG8_SA
#undef PG8_SB
#undef PG8_STAGE
#undef PG8_LDA
#undef PG8_LDB
#undef PG8_MMA
#undef PG8_WAIT_V
#undef PG8_WAIT_L
#undef PG8_BAR
#undef PG8_SCHED
}
}

constexpr int NB = 8, SEQ = 2048, DM = 1024, T = NB * SEQ, DEPTH = 4;
constexpr int INW = 1280, NMOD = 6144, NEXP = 16384;
constexpr float RMS_EPS = 1e-6f, LOG2E = 1.4426950408889634f;
constexpr int NWAVES = 8;
constexpr int NPHASE = 2 + 6 * DEPTH;
#ifndef MK_PER_PHASE
#define MK_PER_PHASE 0
#endif

constexpr size_t MiB = 1u << 20;
constexpr size_t WS_CTL = 0, CTL_ZERO_BYTES = 1 * MiB;
constexpr size_t WS_MOD = 1 * MiB;
constexpr size_t WS_WIN = 2 * MiB;
constexpr size_t WS_WOUT = 12 * MiB;
constexpr size_t WS_WQ = 20 * MiB;
constexpr size_t WS_POOLW = 36 * MiB;
constexpr size_t WS_SUBK = 37 * MiB;
constexpr size_t WS_H = 38 * MiB;
constexpr size_t WS_PROJ = 70 * MiB;
constexpr size_t WS_Y = 110 * MiB;
constexpr size_t WS_QP = 142 * MiB;
constexpr size_t WS_U8 = 206 * MiB;
constexpr size_t WS_V8 = 270 * MiB;
constexpr size_t WS_SU = 334 * MiB;
constexpr size_t WS_SV = 335 * MiB;
constexpr size_t WS_GG2 = 336 * MiB;
constexpr size_t WS_SHQ = 337 * MiB;
constexpr size_t WS_SS = 338 * MiB;
constexpr size_t WS_END = 340 * MiB;
constexpr int CW_BAR = 4096;
constexpr int CW_RANK = 16384;

constexpr int LDS_BYTES = 150528;
constexpr int MISC_OFF = 148480;

#define GAS __attribute__((address_space(1)))
#define LAS __attribute__((address_space(3)))
typedef unsigned short bf16;
typedef unsigned v4u __attribute__((ext_vector_type(4)));
typedef unsigned v2u __attribute__((ext_vector_type(2)));
typedef float f32x4 __attribute__((ext_vector_type(4)));
typedef float f32x16 __attribute__((ext_vector_type(16)));
typedef short bf16x8 __attribute__((ext_vector_type(8)));
typedef float f32x2_t __attribute__((ext_vector_type(2)));
typedef __bf16 bf16x2_t __attribute__((ext_vector_type(2)));
typedef GAS unsigned gu32;
#define RLX_AGENT __ATOMIC_RELAXED, __HIP_MEMORY_SCOPE_AGENT
#define LDS_WAIT() asm volatile("s_waitcnt lgkmcnt(0)" ::: "memory")
__device__ __forceinline__ unsigned pk2(float lo, float hi) { f32x2_t v = {lo, hi}; bf16x2_t b = __builtin_convertvector(v, bf16x2_t); return __builtin_bit_cast(unsigned, b); }
__device__ __forceinline__ float bflo(unsigned w) { return __uint_as_float(w << 16); }
__device__ __forceinline__ float bfhi(unsigned w) { return __uint_as_float(w & 0xffff0000u); }
__device__ __forceinline__ float dot2_bf16(unsigned w, unsigned x, float acc) { return __builtin_amdgcn_fdot2_f32_bf16(__builtin_bit_cast(bf16x2_t, w), __builtin_bit_cast(bf16x2_t, x), acc, false); }
#define DPP_XOR1 0xB1
#define DPP_XOR2 0x4E
#define DPP_HMIRROR 0x141
#define DPP_MIRROR 0x140
#define DPP_ROR8 0x128
template <int CTRL> __device__ __forceinline__ int dpp_i(int v) { return __builtin_amdgcn_update_dpp(0, v, CTRL, 0xf, 0xf, true); }
template <int CTRL> __device__ __forceinline__ float dpp_f(float v) { return __int_as_float(__builtin_amdgcn_update_dpp(0, __float_as_int(v), CTRL, 0xf, 0xf, true)); }
__device__ __forceinline__ void swap32(unsigned& a, unsigned& b) { auto r = __builtin_amdgcn_permlane32_swap(a, b, false, false); a = r[0]; b = r[1]; }
__device__ __forceinline__ void swap16(unsigned& a, unsigned& b) { auto r = __builtin_amdgcn_permlane16_swap(a, b, false, false); a = r[0]; b = r[1]; }
__device__ __forceinline__ float sum32(float v) { unsigned a = __float_as_uint(v), b = a; swap32(a, b); return __uint_as_float(a) + __uint_as_float(b); }
__device__ __forceinline__ float xchg32(float v, int hi) { unsigned a = __float_as_uint(v), b = a; swap32(a, b); return __uint_as_float(hi ? a : b); }
__device__ __forceinline__ float wave_sum(float v) {
    v += dpp_f<DPP_XOR1>(v); v += dpp_f<DPP_XOR2>(v); v += dpp_f<DPP_HMIRROR>(v); v += dpp_f<DPP_MIRROR>(v);
    { unsigned a = __float_as_uint(v), b = a; swap16(a, b); v = __uint_as_float(a) + __uint_as_float(b); }
    return sum32(v);
}
__device__ __forceinline__ float wave_max(float v) {
    v = fmaxf(v, dpp_f<DPP_XOR1>(v)); v = fmaxf(v, dpp_f<DPP_XOR2>(v)); v = fmaxf(v, dpp_f<DPP_HMIRROR>(v)); v = fmaxf(v, dpp_f<DPP_MIRROR>(v));
    { unsigned a = __float_as_uint(v), b = a; swap16(a, b); v = fmaxf(__uint_as_float(a), __uint_as_float(b)); }
    { unsigned a = __float_as_uint(v), b = a; swap32(a, b); v = fmaxf(__uint_as_float(a), __uint_as_float(b)); }
    return v;
}
__device__ __forceinline__ f32x16 mfma32(bf16x8 a, bf16x8 b, f32x16 c) { return __builtin_amdgcn_mfma_f32_32x32x16_bf16(a, b, c, 0, 0, 0); }
__device__ __forceinline__ f32x16 zero16() { f32x16 z;
#pragma unroll
    for (int i = 0; i < 16; ++i) z[i] = 0.f;
    return z; }
#define XB_TMO      128
#define XB_XCNT(j)  (256  + 64 * (j))
#define XB_XSUB(j)  (1280 + 64 * (j))
#define XB_XGEN(j)  (2304 + 64 * (j))
#define XB_TOP      3328
#define XB_TOPGEN   3392
#define XCD_BAR_WORDS 3456
#define XB_SPIN_CAP (1u << 18)

__device__ __forceinline__ unsigned xb_ld(unsigned* p)              { return __hip_atomic_load(p, __ATOMIC_RELAXED, __HIP_MEMORY_SCOPE_AGENT); }
__device__ __forceinline__ unsigned xb_add(unsigned* p, unsigned v) { return __hip_atomic_fetch_add(p, v, __ATOMIC_RELAXED, __HIP_MEMORY_SCOPE_AGENT); }
__device__ __forceinline__ unsigned xb_xcc_id() { return (unsigned)__builtin_amdgcn_s_getreg((3 << 11) | 20) & 0xFu; }
#define XB_SPIN(cond, bar) do { unsigned _sp = 0; while (cond) { __builtin_amdgcn_s_sleep(1); \
    if ((++_sp & 255u) == 0u) { if (xb_ld(&(bar)[XB_TMO])) break; if (_sp > XB_SPIN_CAP) { atomicAdd(&(bar)[XB_TMO], 1u); break; } } } } while (0)

struct XcdBarrier {
    unsigned* bar; unsigned x;
    volatile LAS unsigned* st;
};

__device__ __forceinline__ XcdBarrier xcd_barrier_post(unsigned* bar, volatile LAS unsigned* st) {
    XcdBarrier b; b.bar = bar; b.x = xb_xcc_id(); b.st = st;
    if (threadIdx.x == 0) (void)xb_add(&bar[XB_XCNT(b.x)], 1u);
    return b;
}
__device__ __forceinline__ void xcd_barrier_complete(unsigned* bar, unsigned x, unsigned& nloc, unsigned& nx) {
    const unsigned G = gridDim.x * gridDim.y * gridDim.z;
    unsigned sum, cnt, mine, sp = 0u;
    for (;;) {
        sum = 0u; cnt = 0u; mine = 0u;
#pragma unroll
        for (unsigned j = 0; j < 16; ++j) { const unsigned c = xb_ld(&bar[XB_XCNT(j)]); sum += c; cnt += (c > 0u) ? 1u : 0u; mine = (j == x) ? c : mine; }
        if (sum == G) break;
        __builtin_amdgcn_s_sleep(1);
        if ((++sp & 255u) == 0u) { if (xb_ld(&bar[XB_TMO])) break; if (sp > XB_SPIN_CAP) { atomicAdd(&bar[XB_TMO], 1u); break; } }
    }
    nloc = mine > 0u ? mine : 1u; nx = cnt > 0u ? cnt : 1u;
}

__device__ __forceinline__ void xcd_barrier(const XcdBarrier& b) {
    asm volatile("s_waitcnt vmcnt(0)" ::: "memory");
    __syncthreads();
    if (threadIdx.x == 0) {
        unsigned* bar = b.bar;
        __builtin_amdgcn_s_waitcnt(0);
        unsigned nloc = b.st[0], nx = b.st[1];
        if (nloc == 0u) { xcd_barrier_complete(bar, b.x, nloc, nx); b.st[0] = nloc; b.st[1] = nx; }
        const unsigned old = xb_add(&bar[XB_XSUB(b.x)], 1u);
        const unsigned gen = old / nloc;
        if (old + 1u == (gen + 1u) * nloc) {
            __builtin_amdgcn_fence(__ATOMIC_RELEASE, "agent");
            asm volatile("s_waitcnt vmcnt(0)" ::: "memory");
            const unsigned og = xb_add(&bar[XB_TOP], 1u);
            const unsigned tg = og / nx;
            if (og + 1u == (tg + 1u) * nx) xb_add(&bar[XB_TOPGEN], 1u);
            else XB_SPIN(xb_ld(&bar[XB_TOPGEN]) == tg, bar);
            __builtin_amdgcn_fence(__ATOMIC_ACQUIRE, "agent");
            xb_add(&bar[XB_XGEN(b.x)], 1u);
            asm volatile("s_waitcnt vmcnt(0)" ::: "memory");
        } else {
            XB_SPIN(xb_ld(&bar[XB_XGEN(b.x)]) == gen, bar);
            __builtin_amdgcn_fence(__ATOMIC_ACQUIRE, "agent");
            asm volatile("s_waitcnt vmcnt(0)" ::: "memory");
        }
    }
    __syncthreads();
}
#ifndef GPRIO
#define GPRIO 1
#endif
__device__ __forceinline__ int dot4_first(unsigned a, unsigned b) { int d; asm("v_dot4_i32_i8 %0, %1, %2, 0" : "=v"(d) : "v"(a), "v"(b)); return d; }
#ifndef STAG_U
#define STAG_U 21
#endif
#ifndef STAG_V
#define STAG_V 29
#endif

__device__ __forceinline__ void phase_mod(LAS unsigned char* lds, const float* C, const float* w_ada, const float* b_ada, float* MOD, int tid, int bid, int G) {
    LAS float* cond = (LAS float*)lds; LAS float* part = (LAS float*)(lds + 32768);
    for (int i = tid; i < 8192; i += 512) { const int b = i >> 10, k = i & 1023; const float c = C[i]; cond[k * 8 + b] = c / (1.f + __expf(-c)); }
    __syncthreads();
    const int cg = tid & 31, ks = tid >> 5;
    for (int item = bid; item < 192; item += G) {
        const int col0 = item * 128, l = col0 / NMOD, n0 = col0 - l * NMOD;
        const float* W = w_ada + (size_t)l * DM * NMOD + n0 + cg * 4;
        f32x4 acc[8];
#pragma unroll
        for (int b = 0; b < 8; ++b) acc[b] = (f32x4){0.f, 0.f, 0.f, 0.f};
#pragma unroll 8
        for (int kk = 0; kk < 64; ++kk) {
            const int k = ks * 64 + kk;
            const f32x4 w = *(const f32x4*)(W + (size_t)k * NMOD);
            const f32x4 c0 = *(const LAS f32x4*)(cond + k * 8), c1 = *(const LAS f32x4*)(cond + k * 8 + 4);
#pragma unroll
            for (int b = 0; b < 4; ++b) { acc[b] += c0[b] * w; acc[4 + b] += c1[b] * w; }
        }
#pragma unroll
        for (int b = 0; b < 8; ++b) *(LAS f32x4*)(part + (ks * 8 + b) * 128 + cg * 4) = acc[b];
        __syncthreads();
        for (int o = tid; o < 1024; o += 512) {
            const int b = o >> 7, c = o & 127; float s = b_ada[l * NMOD + n0 + c];
#pragma unroll
            for (int k2 = 0; k2 < 16; ++k2) s += part[(k2 * 8 + b) * 128 + c];
            MOD[((size_t)l * 8 + b) * NMOD + n0 + c] = s;
        }
        __syncthreads();
    }
}
__device__ __forceinline__ void p0_transpose_item(const float* W, int K, int N, bf16* WT, LAS float* scr, int item, int lane) {
    const int nblk = N / 32, kb = item / nblk, nb = item % nblk, k0 = 64 * kb, n0 = 32 * nb;
#pragma unroll 8
    for (int i = 0; i < 32; ++i) { const int kk = 2 * i + (lane >> 5); scr[kk * 33 + (lane & 31)] = W[(size_t)(k0 + kk) * N + n0 + (lane & 31)]; }
    LDS_WAIT(); asm volatile("" ::: "memory");
    const int c = lane & 7;
#pragma unroll
    for (int j = 0; j < 4; ++j) { const int n = (lane >> 3) + 8 * j; const LAS float* s = scr + (8 * c) * 33 + n;
        v4u o; o.x = pk2(s[0 * 33], s[1 * 33]); o.y = pk2(s[2 * 33], s[3 * 33]); o.z = pk2(s[4 * 33], s[5 * 33]); o.w = pk2(s[6 * 33], s[7 * 33]);
        *(v4u*)(WT + (size_t)(n0 + n) * K + k0 + 8 * c) = o; }
    LDS_WAIT(); asm volatile("" ::: "memory");
}
__device__ __forceinline__ void cvt_stream(const float* src, bf16* dst, size_t n8, size_t gt, size_t GT) {
    for (size_t i = gt; i < n8; i += GT) {
        const f32x4 a = __builtin_nontemporal_load((const f32x4*)(src + i * 8)), b = __builtin_nontemporal_load((const f32x4*)(src + i * 8 + 4));
        v4u o; o.x = pk2(a.x, a.y); o.y = pk2(a.z, a.w); o.z = pk2(b.x, b.y); o.w = pk2(b.z, b.w);
        *(v4u*)(dst + i * 8) = o;
    }
}
template <int BIAS>
__device__ __forceinline__ void quant_rows(const float* src, unsigned char* dst, float* scl, int rbeg, int rend, int gw, int NGW, int lane) {
    constexpr int RB = 4;
    for (int r0 = rbeg + gw * RB; r0 < rend; r0 += NGW * RB) {
        f32x4 v[RB][4];
#pragma unroll
        for (int i = 0; i < RB; ++i)
#pragma unroll
            for (int j = 0; j < 4; ++j) v[i][j] = __builtin_nontemporal_load((const f32x4*)(src + (size_t)(r0 + i) * DM + 256 * j + 4 * lane));
#pragma unroll
        for (int i = 0; i < RB; ++i) {
            float m = 0.f;
#pragma unroll
            for (int j = 0; j < 4; ++j) m = fmaxf(m, fmaxf(fmaxf(fabsf(v[i][j].x), fabsf(v[i][j].y)), fmaxf(fabsf(v[i][j].z), fabsf(v[i][j].w))));
            m = wave_max(m);
            const float sc = m > 0.f ? m * (1.f / 127.f) : 1.f, inv = 1.f / sc;
#pragma unroll
            for (int j = 0; j < 4; ++j) {
                const int q0 = (int)rintf(v[i][j].x * inv) + BIAS, q1 = (int)rintf(v[i][j].y * inv) + BIAS, q2 = (int)rintf(v[i][j].z * inv) + BIAS, q3 = (int)rintf(v[i][j].w * inv) + BIAS;
                *(unsigned*)(dst + (size_t)((r0 + i) >> 14) * ((size_t)NEXP * DM) + (size_t)(2 * j + (lane >> 5)) * ((size_t)NEXP * 128) + (size_t)((r0 + i) & (NEXP - 1)) * 128 + ((4 * lane) & 127)) = (unsigned)(q0 & 255) | ((unsigned)(q1 & 255) << 8) | ((unsigned)(q2 & 255) << 16) | ((unsigned)(q3 & 255) << 24); }
            if (lane == 0) scl[r0 + i] = sc;
        }
    }
}
__device__ __forceinline__ void norm_rows_phase(const float* X, const float* gvec, const float* modl, int sh_off, int sc_off, bf16* H, int gw, int NGW, int lane) {
    constexpr int RB = 4;
    for (int m0 = gw * RB; m0 < T; m0 += NGW * RB) {
        f32x4 v[RB][4];
#pragma unroll
        for (int i = 0; i < RB; ++i)
#pragma unroll
            for (int j = 0; j < 4; ++j) v[i][j] = *(const f32x4*)(X + (size_t)(m0 + i) * DM + 256 * j + 4 * lane);
        const float* mb = modl + (size_t)(m0 >> 11) * NMOD;
        f32x4 gg[4], sh[4];
#pragma unroll
        for (int j = 0; j < 4; ++j) { const int k = 256 * j + 4 * lane; gg[j] = *(const f32x4*)(gvec + k) * (1.f + *(const f32x4*)(mb + sc_off + k)); sh[j] = *(const f32x4*)(mb + sh_off + k); }
#pragma unroll
        for (int i = 0; i < RB; ++i) {
            float s = 0.f;
#pragma unroll
            for (int j = 0; j < 4; ++j) s += (v[i][j].x * v[i][j].x + v[i][j].y * v[i][j].y) + (v[i][j].z * v[i][j].z + v[i][j].w * v[i][j].w);
            const float rstd = rsqrtf(wave_sum(s) * (1.f / DM) + RMS_EPS);
#pragma unroll
            for (int j = 0; j < 4; ++j) { const f32x4 o = v[i][j] * rstd * gg[j] + sh[j]; v2u w; w.x = pk2(o.x, o.y); w.y = pk2(o.z, o.w);
                *(v2u*)(H + (size_t)(m0 + i) * DM + 256 * j + 4 * lane) = w; }
        }
    }
}

constexpr int PL_STRIDE = 1040;
constexpr int KL_STRIDE = 144, KL_OFF = 0;
constexpr int VT_STRIDE = 392, VT_OFF = 55296;
constexpr int SSP_OFF = 106496, SSA_OFF = 108544;
__device__ __forceinline__ void unpack8(const v4u w, float (&f)[8]) {
    f[0] = bflo(w.x); f[1] = bfhi(w.x); f[2] = bflo(w.y); f[3] = bfhi(w.y); f[4] = bflo(w.z); f[5] = bfhi(w.z); f[6] = bflo(w.w); f[7] = bfhi(w.w); }
__device__ __forceinline__ v4u pack8(const float (&f)[8]) { v4u o; o.x = pk2(f[0], f[1]); o.y = pk2(f[2], f[3]); o.z = pk2(f[4], f[5]); o.w = pk2(f[6], f[7]); return o; }
template <int WIN>
__device__ __forceinline__ void pool_rows(const bf16* base, int pos0, LAS unsigned char* dst) {
    v4u rw[WIN + 7];
#pragma unroll
    for (int i = 0; i < WIN + 7; ++i) { const int rel = i - (WIN - 1); const bool ok = pos0 + rel >= 0; rw[i] = *(const v4u*)(base + (ptrdiff_t)(ok ? rel : 0) * INW); if (!ok) rw[i] = (v4u){0u, 0u, 0u, 0u}; }
    float sum[8], f[8];
#pragma unroll
    for (int k = 0; k < 8; ++k) sum[k] = 0.f;
#pragma unroll
    for (int i = 0; i < WIN - 1; ++i) { unpack8(rw[i], f);
#pragma unroll
        for (int k = 0; k < 8; ++k) sum[k] += f[k]; }
#pragma unroll
    for (int r = 0; r < 8; ++r) {
        float cur[8]; unpack8(rw[r + WIN - 1], cur);
#pragma unroll
        for (int k = 0; k < 8; ++k) sum[k] += cur[k];
        const int pos = pos0 + r; const float inv = 1.f / (float)((pos + 1) < WIN ? (pos + 1) : WIN);
#pragma unroll
        for (int k = 0; k < 8; ++k) f[k] = sum[k] * inv - cur[k];
        *(LAS v4u*)(dst + r * PL_STRIDE) = pack8(f);
        unpack8(rw[r], f);
#pragma unroll
        for (int k = 0; k < 8; ++k) sum[k] -= f[k];
    }
}
__device__ __forceinline__ void phase_mix(LAS unsigned char* lds, const bf16* PROJ, const bf16* PWT, const float* pool_scale, const float* qg, const float* kg,
                                          const float* sinks, const float* mixg, bf16* Y, int tid, int vcu, int G) {
    const int lane = tid & 63, wave = __builtin_amdgcn_readfirstlane(tid >> 6), l31 = lane & 31, hi = lane >> 5;
    LAS float* SSP = (LAS float*)(lds + SSP_OFF); LAS float* SSA = (LAS float*)(lds + SSA_OFF);
    for (int u = vcu; u < 256; u += G) {
        const int b = u >> 5, t0 = (u & 31) * 64; const size_t row0 = (size_t)b * SEQ + t0;
        {
            const int g = wave >> 1, t128 = (wave & 1) * 64 + lane, ch = t128 & 15, rseg = t128 >> 4, col = g * 128 + ch * 8;
            const int r0 = rseg * 8, pos0 = t0 + r0;
            const bf16* base = PROJ + ((size_t)b * SEQ + pos0) * INW + col;
            switch (g) {
                case 0: pool_rows<2>(base, pos0, lds + r0 * PL_STRIDE + col * 2); break;
                case 1: pool_rows<4>(base, pos0, lds + r0 * PL_STRIDE + col * 2); break;
                case 2: pool_rows<8>(base, pos0, lds + r0 * PL_STRIDE + col * 2); break;
                default: pool_rows<16>(base, pos0, lds + r0 * PL_STRIDE + col * 2); break;
            }
        }
        __syncthreads();
        bf16x8 afw[8][2];
        {
            const bf16* Wt = PWT + ((size_t)(wave >> 1) * 128 + (wave & 1) * 64) * 128;
#pragma unroll
            for (int s = 0; s < 8; ++s)
#pragma unroll
                for (int dt = 0; dt < 2; ++dt) afw[s][dt] = *(const bf16x8*)(Wt + (size_t)(dt * 32 + l31) * 128 + s * 16 + hi * 8);
        }
        __builtin_amdgcn_sched_barrier(0);
        f32x16 pacc[2][2];
        {
            const int g = wave >> 1, dh = wave & 1;
            const float* ps = pool_scale + g * 128 + dh * 64 + 4 * hi;
            f32x4 psc[2][4];
#pragma unroll
            for (int dt = 0; dt < 2; ++dt)
#pragma unroll
                for (int i = 0; i < 4; ++i) psc[dt][i] = *(const f32x4*)(ps + dt * 32 + 8 * i);
#pragma unroll
            for (int a = 0; a < 2; ++a)
#pragma unroll
                for (int c = 0; c < 2; ++c) pacc[a][c] = zero16();
#pragma unroll
            for (int s = 0; s < 8; ++s) {
                bf16x8 bfr[2];
#pragma unroll
                for (int tt = 0; tt < 2; ++tt) bfr[tt] = *(const LAS bf16x8*)(lds + (tt * 32 + l31) * PL_STRIDE + (g * 128 + s * 16 + hi * 8) * 2);
#pragma unroll
                for (int tt = 0; tt < 2; ++tt)
#pragma unroll
                    for (int dt = 0; dt < 2; ++dt) pacc[tt][dt] = mfma32(afw[s][dt], bfr[tt], pacc[tt][dt]);
            }
#pragma unroll
            for (int tt = 0; tt < 2; ++tt) {
                float ss = 0.f;
#pragma unroll
                for (int dt = 0; dt < 2; ++dt)
#pragma unroll
                    for (int i = 0; i < 4; ++i) { const f32x4 sc = psc[dt][i];
#pragma unroll
                        for (int e = 0; e < 4; ++e) { const float v = pacc[tt][dt][4 * i + e] * sc[e]; pacc[tt][dt][4 * i + e] = v; ss += v * v; } }
                ss = sum32(ss);
                if (hi == 0) SSP[(tt * 32 + l31) * 8 + wave] = ss;
            }
        }
        __syncthreads();
        {
            const int cb = (wave >> 1) * 128 + (wave & 1) * 64 + 4 * hi;
#pragma unroll
            for (int tt = 0; tt < 2; ++tt) {
                const int tok = tt * 32 + l31;
                const f32x4 s0 = *(const LAS f32x4*)(SSP + tok * 8), s1 = *(const LAS f32x4*)(SSP + tok * 8 + 4);
                const float rp = rsqrtf(((s0.x + s0.y) + (s0.z + s0.w) + (s1.x + s1.y) + (s1.z + s1.w)) * (1.f / 512.f) + RMS_EPS);
#pragma unroll
                for (int dt = 0; dt < 2; ++dt)
#pragma unroll
                    for (int i = 0; i < 4; ++i) { const int c = cb + dt * 32 + 8 * i; const f32x4 mg = *(const f32x4*)(mixg + c);
                        v2u w; w.x = pk2(pacc[tt][dt][4 * i] * rp * mg.x, pacc[tt][dt][4 * i + 1] * rp * mg.y); w.y = pk2(pacc[tt][dt][4 * i + 2] * rp * mg.z, pacc[tt][dt][4 * i + 3] * rp * mg.w);
                        *(LAS v2u*)(lds + tok * PL_STRIDE + c * 2) = w; }
            }
            __syncthreads();
#pragma unroll
            for (int i = 0; i < 8; ++i) { const int ck = tid + 512 * i, r = ck >> 6, pc = ck & 63; *(v4u*)(Y + (row0 + r) * DM + pc * 8) = *(const LAS v4u*)(lds + r * PL_STRIDE + pc * 16); }
            asm volatile("s_waitcnt lgkmcnt(0)" ::: "memory"); __builtin_amdgcn_s_barrier(); asm volatile("" ::: "memory");
        }
        const int hh = wave, kvh = hh >> 2;
        v4u qraw[2][4];
        int l31q = l31; asm volatile("" : "+v"(l31q));
#pragma unroll
        for (int qt = 0; qt < 2; ++qt) {
            const bf16* qp = PROJ + (row0 + qt * 32 + l31q) * INW + 512 + hh * 64 + hi * 8;
#pragma unroll
            for (int s = 0; s < 4; ++s) qraw[qt][s] = *(const v4u*)(qp + s * 16);
        }
        __builtin_amdgcn_sched_barrier(0);
        {
            const int part = tid & 7;
            const f32x4 g0 = *(const f32x4*)(kg + part * 8), g1 = *(const f32x4*)(kg + part * 8 + 4);
#pragma unroll 1
            for (int hb = 0; hb < 6; hb += 3) {
            v4u wk[3], wv[3];
#pragma unroll
            for (int i = 0; i < 3; ++i) {
                const int c = tid + 512 * (hb + i), kv = c / 1536, rem = c - kv * 1536, key = rem >> 3, kpos = t0 - 128 + key;
                const bf16* src = PROJ + ((size_t)b * SEQ + (kpos >= 0 ? kpos : 0)) * INW + 1024 + kv * 64 + part * 8;
                wk[i] = *(const v4u*)src; wv[i] = *(const v4u*)(src + 128);
            }
            __builtin_amdgcn_sched_barrier(0);
#pragma unroll
            for (int i = 0; i < 3; ++i) {
                const int c = tid + 512 * (hb + i), kv = c / 1536, rem = c - kv * 1536, key = rem >> 3, kpos = t0 - 128 + key;
                if (kpos < 0) { wk[i] = (v4u){0u, 0u, 0u, 0u}; wv[i] = (v4u){0u, 0u, 0u, 0u}; }
                float f[8]; unpack8(wk[i], f);
                float ss = 0.f;
#pragma unroll
                for (int k = 0; k < 8; ++k) ss += f[k] * f[k];
                ss += dpp_f<DPP_XOR1>(ss); ss += dpp_f<DPP_XOR2>(ss); ss += dpp_f<DPP_HMIRROR>(ss);
                const float rstd = rsqrtf(ss * (1.f / 64.f) + RMS_EPS);
                f[0] *= rstd * g0.x; f[1] *= rstd * g0.y; f[2] *= rstd * g0.z; f[3] *= rstd * g0.w; f[4] *= rstd * g1.x; f[5] *= rstd * g1.y; f[6] *= rstd * g1.z; f[7] *= rstd * g1.w;
                *(LAS v4u*)(lds + KL_OFF + (kv * 192 + key) * KL_STRIDE + part * 16) = pack8(f);
                LAS unsigned short* vt = (LAS unsigned short*)(lds + VT_OFF + (kv * 64 + part * 8) * VT_STRIDE + key * 2);
                vt[0 * (VT_STRIDE / 2)] = (unsigned short)(wv[i].x & 0xffffu); vt[1 * (VT_STRIDE / 2)] = (unsigned short)(wv[i].x >> 16);
                vt[2 * (VT_STRIDE / 2)] = (unsigned short)(wv[i].y & 0xffffu); vt[3 * (VT_STRIDE / 2)] = (unsigned short)(wv[i].y >> 16);
                vt[4 * (VT_STRIDE / 2)] = (unsigned short)(wv[i].z & 0xffffu); vt[5 * (VT_STRIDE / 2)] = (unsigned short)(wv[i].z >> 16);
                vt[6 * (VT_STRIDE / 2)] = (unsigned short)(wv[i].w & 0xffffu); vt[7 * (VT_STRIDE / 2)] = (unsigned short)(wv[i].w >> 16);
                __builtin_amdgcn_sched_barrier(0);
            }
            }
        }
        bf16x8 qf[2][4];
#pragma unroll
        for (int qt = 0; qt < 2; ++qt) {
            float f[4][8]; float ss = 0.f;
#pragma unroll
            for (int s = 0; s < 4; ++s) { unpack8(qraw[qt][s], f[s]);
#pragma unroll
                for (int k = 0; k < 8; ++k) ss += f[s][k] * f[s][k]; }
            ss = sum32(ss);
            const float rstd = rsqrtf(ss * (1.f / 64.f) + RMS_EPS) * (0.125f * LOG2E);
#pragma unroll
            for (int s = 0; s < 4; ++s) { const f32x4 g0 = *(const f32x4*)(qg + s * 16 + hi * 8), g1 = *(const f32x4*)(qg + s * 16 + hi * 8 + 4);
                f[s][0] *= rstd * g0.x; f[s][1] *= rstd * g0.y; f[s][2] *= rstd * g0.z; f[s][3] *= rstd * g0.w; f[s][4] *= rstd * g1.x; f[s][5] *= rstd * g1.y; f[s][6] *= rstd * g1.z; f[s][7] *= rstd * g1.w;
                qf[qt][s] = __builtin_bit_cast(bf16x8, pack8(f[s])); }
        }
        __syncthreads();
        f32x16 o[2][2];
#pragma unroll
        for (int a = 0; a < 2; ++a)
#pragma unroll
            for (int c = 0; c < 2; ++c) o[a][c] = zero16();
        float lsum[2] = {0.f, 0.f};
        const float slope = exp2f(-(float)(hh + 1)) * LOG2E;
        const int e_l = l31 - 4 * hi, kmin = t0 < 128 ? 128 - t0 : 0;
        const float se = slope * (float)e_l;
#define ATT_TILE(kti, MODE) do { const int kt = qt + (kti); if (kt * 32 >= kmin) { \
                f32x16 sc = zero16(); \
_Pragma("unroll") \
                for (int s = 0; s < 4; ++s) { const bf16x8 kf = *(const LAS bf16x8*)(lds + KL_OFF + (kvh * 192 + kt * 32 + l31) * KL_STRIDE + (s * 16 + hi * 8) * 2); sc = mfma32(kf, qf[qt][s], sc); } \
                const float nb = -slope * (float)(128 - 32 * kti) - se; \
                float p[16]; float ls = 0.f; \
_Pragma("unroll") \
                for (int r = 0; r < 16; ++r) { const int cr = (r & 3) + 8 * (r >> 2); \
                    float arg = __builtin_fmaf(slope, (float)cr, sc[r] + nb); \
                    if (MODE == 0) arg = (cr > e_l) ? arg : -200.f; \
                    if (MODE == 2) arg = (cr <= e_l) ? arg : -200.f; \
                    p[r] = __builtin_amdgcn_exp2f(arg); ls += p[r]; } \
                lsum[qt] += ls; \
                bf16x8 pf[2]; \
_Pragma("unroll") \
                for (int s2 = 0; s2 < 2; ++s2) { v4u w; w.x = pk2(p[8 * s2], p[8 * s2 + 1]); w.y = pk2(p[8 * s2 + 2], p[8 * s2 + 3]); w.z = pk2(p[8 * s2 + 4], p[8 * s2 + 5]); w.w = pk2(p[8 * s2 + 6], p[8 * s2 + 7]); pf[s2] = __builtin_bit_cast(bf16x8, w); } \
_Pragma("unroll") \
                for (int dt = 0; dt < 2; ++dt) \
_Pragma("unroll") \
                    for (int s2 = 0; s2 < 2; ++s2) { const LAS unsigned char* ap = lds + VT_OFF + (kvh * 64 + dt * 32 + l31) * VT_STRIDE + (kt * 32 + s2 * 16 + hi * 4) * 2; \
                        const v2u a0 = *(const LAS v2u*)ap, a1 = *(const LAS v2u*)(ap + 16); v4u av; av.x = a0.x; av.y = a0.y; av.z = a1.x; av.w = a1.y; \
                        o[qt][dt] = mfma32(__builtin_bit_cast(bf16x8, av), pf[s2], o[qt][dt]); } } } while (0)
#pragma unroll
        for (int qt = 0; qt < 2; ++qt) {
            ATT_TILE(0, 0);
#pragma unroll 1
            for (int kti = 1; kti < 4; ++kti) ATT_TILE(kti, 1);
            ATT_TILE(4, 2);
        }
#undef ATT_TILE
        const float sink = exp2f(sinks[hh] * LOG2E);
#pragma unroll
        for (int qt = 0; qt < 2; ++qt) {
            const float lt = sum32(lsum[qt]); const float inv = 1.f / (lt + sink); float ss = 0.f;
#pragma unroll
            for (int dt = 0; dt < 2; ++dt)
#pragma unroll
                for (int r = 0; r < 16; ++r) { const float v = o[qt][dt][r] * inv; o[qt][dt][r] = v; ss += v * v; }
            ss = sum32(ss);
            if (hi == 0) SSA[(qt * 32 + l31) * 8 + hh] = ss;
        }
        __syncthreads();
        {
            const int cb = hh * 64 + 4 * hi;
#pragma unroll
            for (int tt = 0; tt < 2; ++tt) {
                const int tok = tt * 32 + l31;
                const f32x4 s0 = *(const LAS f32x4*)(SSA + tok * 8), s1 = *(const LAS f32x4*)(SSA + tok * 8 + 4);
                const float ra = rsqrtf(((s0.x + s0.y) + (s0.z + s0.w) + (s1.x + s1.y) + (s1.z + s1.w)) * (1.f / 512.f) + RMS_EPS);
#pragma unroll
                for (int dt = 0; dt < 2; ++dt)
#pragma unroll
                    for (int i = 0; i < 4; ++i) { const int c = cb + dt * 32 + 8 * i; const f32x4 mg = *(const f32x4*)(mixg + 512 + c);
                        v2u w; w.x = pk2(o[tt][dt][4 * i] * ra * mg.x, o[tt][dt][4 * i + 1] * ra * mg.y); w.y = pk2(o[tt][dt][4 * i + 2] * ra * mg.z, o[tt][dt][4 * i + 3] * ra * mg.w);
                        *(LAS v2u*)(lds + tok * PL_STRIDE + c * 2) = w; }
            }
            __syncthreads();
#pragma unroll
            for (int i = 0; i < 8; ++i) { const int ck = tid + 512 * i, r = ck >> 6, pc = ck & 63; *(v4u*)(Y + (row0 + r) * DM + 512 + pc * 8) = *(const LAS v4u*)(lds + r * PL_STRIDE + pc * 16); }
        }
        __syncthreads();
    }
}

#ifndef VREP
#define VREP 1
#endif
#ifndef UREP
#define UREP 1
#endif
#ifndef TOPK_REP
#define TOPK_REP 1
#endif
#ifndef GATHER_PARTS
#define GATHER_PARTS 3
#endif
#ifndef PEER_PARTS
#define PEER_PARTS 3
#endif
constexpr int SK_STRIDE = 272, SK_OFF = 0;
constexpr int EI_OFF = 98304, EG_OFF = 131072;
constexpr int TKS_OFF = 69632;
constexpr int SHS_OFF = 147456;
constexpr int W_OFF = 0, H8_OFF = 32768;
#define CE_DESC(a, b) do { const float _h = fmaxf(a, b), _l = fminf(a, b); a = _h; b = _l; } while (0)
__device__ __forceinline__ void sort16(float (&L)[16]) { CE_DESC(L[0], L[1]); CE_DESC(L[2], L[3]); CE_DESC(L[4], L[5]); CE_DESC(L[6], L[7]); CE_DESC(L[8], L[9]); CE_DESC(L[10], L[11]); CE_DESC(L[12], L[13]); CE_DESC(L[14], L[15]); CE_DESC(L[0], L[2]); CE_DESC(L[1], L[3]); CE_DESC(L[4], L[6]); CE_DESC(L[5], L[7]); CE_DESC(L[8], L[10]); CE_DESC(L[9], L[11]); CE_DESC(L[12], L[14]); CE_DESC(L[13], L[15]); CE_DESC(L[1], L[2]); CE_DESC(L[5], L[6]); CE_DESC(L[9], L[10]); CE_DESC(L[13], L[14]); CE_DESC(L[0], L[4]); CE_DESC(L[1], L[5]); CE_DESC(L[2], L[6]); CE_DESC(L[3], L[7]); CE_DESC(L[8], L[12]); CE_DESC(L[9], L[13]); CE_DESC(L[10], L[14]); CE_DESC(L[11], L[15]); CE_DESC(L[2], L[4]); CE_DESC(L[3], L[5]); CE_DESC(L[10], L[12]); CE_DESC(L[11], L[13]); CE_DESC(L[1], L[2]); CE_DESC(L[3], L[4]); CE_DESC(L[5], L[6]); CE_DESC(L[9], L[10]); CE_DESC(L[11], L[12]); CE_DESC(L[13], L[14]); CE_DESC(L[0], L[8]); CE_DESC(L[1], L[9]); CE_DESC(L[2], L[10]); CE_DESC(L[3], L[11]); CE_DESC(L[4], L[12]); CE_DESC(L[5], L[13]); CE_DESC(L[6], L[14]); CE_DESC(L[7], L[15]); CE_DESC(L[4], L[8]); CE_DESC(L[5], L[9]); CE_DESC(L[6], L[10]); CE_DESC(L[7], L[11]); CE_DESC(L[2], L[4]); CE_DESC(L[3], L[5]); CE_DESC(L[6], L[8]); CE_DESC(L[7], L[9]); CE_DESC(L[10], L[12]); CE_DESC(L[11], L[13]); CE_DESC(L[1], L[2]); CE_DESC(L[3], L[4]); CE_DESC(L[5], L[6]); CE_DESC(L[7], L[8]); CE_DESC(L[9], L[10]); CE_DESC(L[11], L[12]); CE_DESC(L[13], L[14]); }
__device__ __forceinline__ void bmerge16(float (&M)[16]) {
#pragma unroll
    for (int d = 8; d >= 1; d >>= 1)
#pragma unroll
        for (int i = 0; i < 16; ++i) if ((i & d) == 0) CE_DESC(M[i], M[i + d]);
}
__device__ __forceinline__ void merge16(float (&Tt)[16], const float (&C)[16]) {
#pragma unroll
    for (int i = 0; i < 16; ++i) Tt[i] = fmaxf(Tt[i], C[15 - i]);
    bmerge16(Tt);
}
__device__ __forceinline__ float clrbits(float v, unsigned m) { return __uint_as_float(__float_as_uint(v) & ~m); }
__device__ __forceinline__ void phase_peer(LAS unsigned char* lds, const bf16* QP, const bf16* SUBK, const unsigned char* U8, const unsigned char* V8, const float* SU, const float* SV, float* X, const float* modl, const float* n2g,
                                           const float* n1g_next, const float* mod_next, bf16* H, int tid, int bid, int G, float xscale) {
    const int lane = tid & 63, wave = __builtin_amdgcn_readfirstlane(tid >> 6), l31 = lane & 31, hi = lane >> 5;
    LAS unsigned* EI = (LAS unsigned*)(lds + EI_OFF); LAS _Float16* EG = (LAS _Float16*)(lds + EG_OFF);
    for (int u = bid; u < 256; u += G) {
        const size_t row0 = (size_t)u * 64; const int b = u >> 5;
        for (int i = tid; i < 4096; i += 512) { const int row = i >> 4, ch = i & 15; *(LAS v4u*)(lds + SK_OFF + row * SK_STRIDE + ch * 16) = *(const v4u*)(SUBK + row * 128 + ch * 8); }
        __syncthreads();
        LAS unsigned char* IJT = lds + TKS_OFF;
        LAS unsigned char* NB = lds + TKS_OFF + 64 + (wave * 64 + lane) * 32;
        if (tid < 50) { const int c = tid;
            const int ii = (c >= 16) + (c >= 24) + (c >= 29) + (c >= 33) + (c >= 36) + (c >= 38) + (c >= 40) + (c >= 42) + (c > 42 ? c - 42 : 0);
            const int st = ii == 0 ? 0 : ii == 1 ? 16 : ii == 2 ? 24 : ii == 3 ? 29 : ii == 4 ? 33 : ii == 5 ? 36 : ii == 6 ? 38 : ii == 7 ? 40 : 34 + ii;
            IJT[c] = (unsigned char)((ii << 4) | (c - st)); }
        __syncthreads();
#pragma unroll 1
        for (int tt2 = 0; tt2 < ((PEER_PARTS & 1) ? 2 * TOPK_REP : 0); ++tt2) {
            const int tt = tt2 & 1;
            float L[2][16];
#pragma unroll
            for (int p = 0; p < 2; ++p) {
                bf16x8 qf[8];
                const int rg = (int)row0 + tt * 32 + l31, rr = rg & 255;
                const bf16* qp = QP + ((size_t)(rg >> 8) * 8 + wave) * 65536 + ((((rr >> 7) * 4 + ((rr >> 4) & 3)) * 2 + p) * 4096) + (((rr >> 6) & 1) * 4 * 64 + (rr & 15)) * 8;
#pragma unroll
                for (int s = 0; s < 8; ++s) qf[s] = *(const bf16x8*)(qp + ((s >> 1) * 64 + ((2 * s + hi) & 3) * 16) * 8);
                float Tt[16];
#pragma unroll
                for (int np = 0; np < 2; ++np) {
                    f32x16 acc[2]; acc[0] = zero16(); acc[1] = zero16();
#pragma unroll
                    for (int s = 0; s < 8; ++s)
#pragma unroll
                        for (int n2 = 0; n2 < 2; ++n2) { const bf16x8 kf = *(const LAS bf16x8*)(lds + SK_OFF + (p * 128 + (np * 2 + n2) * 32 + l31) * SK_STRIDE + (s * 16 + hi * 8) * 2); acc[n2] = mfma32(kf, qf[s], acc[n2]); }
#pragma unroll
                    for (int n2 = 0; n2 < 2; ++n2) {
                        float C[16];
#pragma unroll
                        for (int r = 0; r < 16; ++r) C[r] = __uint_as_float((__float_as_uint(acc[n2][r]) & ~127u) | (unsigned)((np * 2 + n2) * 32 + (r & 3) + 8 * (r >> 2)));
                        sort16(C);
                        if (np == 0 && n2 == 0) {
#pragma unroll
                            for (int i = 0; i < 16; ++i) Tt[i] = C[i];
                        } else merge16(Tt, C);
                    }
                }
#pragma unroll
                for (int i = 0; i < 16; ++i) Tt[i] = __uint_as_float(__float_as_uint(Tt[i]) | ((unsigned)hi << 2));
                float M[16];
#pragma unroll
                for (int i = 0; i < 16; ++i) M[i] = xchg32(Tt[i], hi);
                merge16(Tt, M);
#pragma unroll
                for (int i = 0; i < 16; ++i) L[p][i] = Tt[i];
            }
            float A1[16], B2[16];
#pragma unroll
            for (int i = 0; i < 16; ++i) { A1[i] = clrbits(L[0][i], 127u); B2[i] = clrbits(L[1][i], 127u); }
#define CAND(i, j, c) __uint_as_float((__float_as_uint(A1[i] + B2[j]) & ~127u) | (unsigned)(c))
            float Cc[16];
#pragma unroll
            for (int j = 0; j < 16; ++j) Cc[j] = CAND(0, j, j);
#pragma unroll
            for (int j = 0; j < 8; ++j) Cc[15 - j] = fmaxf(Cc[15 - j], CAND(1, j, 16 + j));
            bmerge16(Cc);
            {
                float Bc[16] = {CAND(2, 0, 24), CAND(2, 1, 25), CAND(2, 2, 26), CAND(2, 3, 27), CAND(2, 4, 28), CAND(3, 0, 29), CAND(3, 1, 30), CAND(3, 2, 31), CAND(3, 3, 32),
                                CAND(4, 0, 33), CAND(4, 1, 34), CAND(4, 2, 35), CAND(5, 0, 36), CAND(5, 1, 37), -INFINITY, -INFINITY};
                sort16(Bc); merge16(Cc, Bc);
                float Dc[16] = {CAND(6, 0, 38), CAND(6, 1, 39), CAND(7, 0, 40), CAND(7, 1, 41), CAND(8, 0, 42), CAND(9, 0, 43), CAND(10, 0, 44), CAND(11, 0, 45), CAND(12, 0, 46),
                                CAND(13, 0, 47), CAND(14, 0, 48), CAND(15, 0, 49), -INFINITY, -INFINITY, -INFINITY, -INFINITY};
                sort16(Dc); merge16(Cc, Dc);
            }
#undef CAND
            const float mx = clrbits(Cc[0], 127u); float ex[16]; float se = 0.f;
#pragma unroll
            for (int k = 0; k < 16; ++k) { ex[k] = __expf(clrbits(Cc[k], 127u) - mx); se += ex[k]; }
            const float inv = 1.f / se;
            {
                v4u n1p, n2p;
#pragma unroll
                for (int q = 0; q < 4; ++q) {
                    n1p[q] = (__float_as_uint(L[0][4 * q]) & 127u) | ((__float_as_uint(L[0][4 * q + 1]) & 127u) << 8) | ((__float_as_uint(L[0][4 * q + 2]) & 127u) << 16) | ((__float_as_uint(L[0][4 * q + 3]) & 127u) << 24);
                    n2p[q] = (__float_as_uint(L[1][4 * q]) & 127u) | ((__float_as_uint(L[1][4 * q + 1]) & 127u) << 8) | ((__float_as_uint(L[1][4 * q + 2]) & 127u) << 16) | ((__float_as_uint(L[1][4 * q + 3]) & 127u) << 24); }
                *(LAS v4u*)NB = n1p; *(LAS v4u*)(NB + 16) = n2p;
            }
#pragma unroll
            for (int k = 0; k < 16; ++k) {
                const unsigned ij = IJT[__float_as_uint(Cc[k]) & 127u];
                const unsigned n1 = NB[ij >> 4], n2 = NB[16 + (ij & 15u)];
                if (hi == 0) { EI[(tt * 32 + l31) * 128 + wave * 16 + k] = (n1 << 14) | (n2 << 7); EG[(tt * 32 + l31) * 128 + wave * 16 + k] = (_Float16)(ex[k] * inv); }
            }
        }
        __syncthreads();
        const float* mb = modl + (size_t)b * NMOD;
        LAS float* Wl = (LAS float*)(lds + W_OFF); LAS unsigned char* H8 = lds + H8_OFF;
        const int j8 = lane & 7, g8 = lane >> 3;
        const int b0 = lane & 1, b1 = (lane >> 1) & 1, b2 = (lane >> 2) & 1, b3 = (lane >> 3) & 1, b4 = (lane >> 4) & 1;
        if (PEER_PARTS & 2) {
        LAS float* SHS = (LAS float*)(lds + SHS_OFF);
        {
            f32x4 gg[4], shv[4];
#pragma unroll
            for (int q = 0; q < 4; ++q) { const int k = 256 * q + 4 * lane; gg[q] = *(const f32x4*)(n2g + k) * (1.f + *(const f32x4*)(mb + 4096 + k)); shv[q] = *(const f32x4*)(mb + 3072 + k); }
#pragma unroll 1
            for (int tq = 0; tq < 2; ++tq) {
                f32x4 xa[4][4];
#pragma unroll
                for (int i = 0; i < 4; ++i)
#pragma unroll
                    for (int q = 0; q < 4; ++q) xa[i][q] = *(const f32x4*)(X + (row0 + wave + 8 * (4 * tq + i)) * DM + 256 * q + 4 * lane);
#pragma unroll
                for (int i = 0; i < 4; ++i) {
                    const int tk = wave + 8 * (4 * tq + i); float ss = 0.f;
#pragma unroll
                    for (int q = 0; q < 4; ++q) ss += (xa[i][q].x * xa[i][q].x + xa[i][q].y * xa[i][q].y) + (xa[i][q].z * xa[i][q].z + xa[i][q].w * xa[i][q].w);
                    const float rstd = rsqrtf(wave_sum(ss) * (1.f / DM) + RMS_EPS);
                    f32x4 h2[4]; float hm = 0.f;
#pragma unroll
                    for (int q = 0; q < 4; ++q) { h2[q] = xa[i][q] * rstd * gg[q] + shv[q];
                        hm = fmaxf(hm, fmaxf(fmaxf(fabsf(h2[q].x), fabsf(h2[q].y)), fmaxf(fabsf(h2[q].z), fabsf(h2[q].w)))); }
                    hm = wave_max(hm);
                    const float sc1 = hm > 0.f ? hm * (1.f / 127.f) : 1.f, hinv = 1.f / sc1;
#pragma unroll
                    for (int q = 0; q < 4; ++q) { const int q0 = (int)rintf(h2[q].x * hinv), q1 = (int)rintf(h2[q].y * hinv), q2 = (int)rintf(h2[q].z * hinv), q3 = (int)rintf(h2[q].w * hinv);
                        *(LAS unsigned*)(H8 + tk * 1024 + 256 * q + 4 * lane) = (unsigned)(q0 & 255) | ((unsigned)(q1 & 255) << 8) | ((unsigned)(q2 & 255) << 16) | ((unsigned)(q3 & 255) << 24); }
                    if (lane == 0) SHS[tk] = sc1;
                }
            }
        }
        v4u bufA[16], bufB[16];
        const unsigned joff = (unsigned)j8 * 16u;
#define PEER_ISSUE(buf, TAB, sl, ti) do { __builtin_amdgcn_sched_barrier(0); { const int tk_ = wave + 8 * (ti); \
            const GAS unsigned char* sb_ = (const GAS unsigned char*)(TAB) + (size_t)(sl) * ((size_t)NEXP * 128); asm volatile("" : "+s"(sb_)); \
            _Pragma("unroll") for (int q_ = 0; q_ < 4; ++q_) { const v4u e4_ = *(const LAS v4u*)(EI + tk_ * 128 + g8 * 16 + 4 * q_); \
                _Pragma("unroll") for (int r_ = 0; r_ < 4; ++r_) buf[4 * q_ + r_] = *(const GAS v4u*)(sb_ + (e4_[r_] | joff)); } } __builtin_amdgcn_sched_barrier(0); } while (0)
#define PEER_DOT(r_, hq_) __builtin_amdgcn_sdot4((int)(r_).w, (int)hq_.w, __builtin_amdgcn_sdot4((int)(r_).z, (int)hq_.z, __builtin_amdgcn_sdot4((int)(r_).y, (int)hq_.y, dot4_first((r_).x, hq_.x), false), false), false)
#define PEER_UCOMP(buf, sl, ti) do { const int tk_ = wave + 8 * (ti); const v4u hq_ = *(const LAS v4u*)(H8 + tk_ * 1024 + (sl) * 128 + j8 * 16); \
              \
            int q8_[8], q4_[4]; \
            _Pragma("unroll") for (int k_ = 0; k_ < 8; ++k_) { const int p0_ = PEER_DOT(buf[k_], hq_), p1_ = PEER_DOT(buf[k_ + 8], hq_); const int snd_ = b2 ? p0_ : p1_, kp_ = b2 ? p1_ : p0_; q8_[k_] = kp_ + dpp_i<DPP_HMIRROR>(snd_); } \
            _Pragma("unroll") for (int k_ = 0; k_ < 4; ++k_) { const int snd_ = b1 ? q8_[k_] : q8_[k_ + 4], kp_ = b1 ? q8_[k_ + 4] : q8_[k_]; q4_[k_] = kp_ + dpp_i<DPP_XOR2>(snd_); } \
            _Pragma("unroll") for (int k_ = 0; k_ < 2; ++k_) { const int snd_ = b0 ? q4_[k_] : q4_[k_ + 2], kp_ = b0 ? q4_[k_ + 2] : q4_[k_]; pa[ti][k_] += kp_ + dpp_i<DPP_XOR1>(snd_); } \
            asm volatile("" : "+v"(pa[ti][0]), "+v"(pa[ti][1])); } while (0)
        int pa[8][2];
#pragma unroll 1
        for (int urep = 0; urep < UREP; ++urep) {
#pragma unroll
        for (int ti = 0; ti < 8; ++ti) { pa[ti][0] = 0; pa[ti][1] = 0; }
        if (wave >= 4) __builtin_amdgcn_s_setprio(GPRIO);
        PEER_ISSUE(bufA, U8, 0, 0);
#pragma unroll 1
        for (int sl = 0; sl < ((GATHER_PARTS & 1) ? 8 : 0); ++sl) {
            if (STAG_U > 0 && wave >= 4) __builtin_amdgcn_s_sleep(STAG_U);
            PEER_ISSUE(bufB, U8, sl, 1); PEER_UCOMP(bufA, sl, 0);
            PEER_ISSUE(bufA, U8, sl, 2); PEER_UCOMP(bufB, sl, 1);
            PEER_ISSUE(bufB, U8, sl, 3); PEER_UCOMP(bufA, sl, 2);
            PEER_ISSUE(bufA, U8, sl, 4); PEER_UCOMP(bufB, sl, 3);
            PEER_ISSUE(bufB, U8, sl, 5); PEER_UCOMP(bufA, sl, 4);
            PEER_ISSUE(bufA, U8, sl, 6); PEER_UCOMP(bufB, sl, 5);
            PEER_ISSUE(bufB, U8, sl, 7); PEER_UCOMP(bufA, sl, 6);
            if (sl < 7) PEER_ISSUE(bufA, U8, sl + 1, 0);
            PEER_UCOMP(bufB, sl, 7);
            __builtin_amdgcn_s_barrier();
        }
        }
        LAS float* SWS = (LAS float*)(lds + SHS_OFF + 256);
        int lane_w = lane; asm volatile("" : "+v"(lane_w));
        LAS unsigned char* W8 = lds + W_OFF;
        float su_[8][2], sv_[8][2];
#pragma unroll
        for (int ti = 0; ti < 8; ++ti) {
            const int tk = wave + 8 * ti;
            const v2u ew = *(const LAS v2u*)(EI + tk * 128 + 2 * lane_w); const unsigned e0 = ew.x >> 7, e1 = ew.y >> 7;
            su_[ti][0] = SU[e0]; su_[ti][1] = SU[e1]; sv_[ti][0] = SV[e0]; sv_[ti][1] = SV[e1];
        }
#pragma unroll
        for (int ti = 0; ti < 8; ++ti) {
            const int tk = wave + 8 * ti;
            typedef _Float16 h2_t __attribute__((ext_vector_type(2)));
            const h2_t gg = *(const LAS h2_t*)(EG + tk * 128 + 2 * lane_w);
            const float shs_t = SHS[tk];
            const float a0 = (float)pa[ti][0] * (shs_t * su_[ti][0]), a1 = (float)pa[ti][1] * (shs_t * su_[ti][1]);
            const float w0 = 0.5f * a0 * (1.f + erff(a0 * 0.70710678118f)) * (float)gg.x * sv_[ti][0], w1 = 0.5f * a1 * (1.f + erff(a1 * 0.70710678118f)) * (float)gg.y * sv_[ti][1];
            const float wm = wave_max(fmaxf(fabsf(w0), fabsf(w1)));
            const float sw = wm > 0.f ? wm * (1.f / 127.f) : 1.f, winv = 1.f / sw;
            const int q0 = (int)rintf(w0 * winv), q1 = (int)rintf(w1 * winv);
            *(LAS unsigned short*)(W8 + tk * 128 + 2 * lane_w) = (unsigned short)((unsigned)(q0 & 255) | ((unsigned)(q1 & 255) << 8));
            if (lane_w == 0) SWS[tk] = sw;
            __builtin_amdgcn_sched_barrier(0);
        }
#define PEER_VCOMP(buf, xpre, g2pre, sl, ti) do { const int tk_ = wave + 8 * (ti); const v4u wq_ = *(const LAS v4u*)(W8 + tk_ * 128 + g8 * 16); int o_[16]; \
            _Pragma("unroll") for (int q_ = 0; q_ < 4; ++q_) _Pragma("unroll") for (int c_ = 0; c_ < 4; ++c_) { \
                const unsigned r0_ = buf[4 * q_][c_], r1_ = buf[4 * q_ + 1][c_], r2_ = buf[4 * q_ + 2][c_], r3_ = buf[4 * q_ + 3][c_]; \
                const unsigned t0_ = __builtin_amdgcn_perm(r1_, r0_, 0x05010400u), t1_ = __builtin_amdgcn_perm(r1_, r0_, 0x07030602u), t2_ = __builtin_amdgcn_perm(r3_, r2_, 0x05010400u), t3_ = __builtin_amdgcn_perm(r3_, r2_, 0x07030602u); \
                o_[4 * c_] = (q_ == 0) ? dot4_first(__builtin_amdgcn_perm(t2_, t0_, 0x05040100u), wq_[q_]) : __builtin_amdgcn_sdot4((int)__builtin_amdgcn_perm(t2_, t0_, 0x05040100u), (int)wq_[q_], o_[4 * c_], false); \
                o_[4 * c_ + 1] = (q_ == 0) ? dot4_first(__builtin_amdgcn_perm(t2_, t0_, 0x07060302u), wq_[q_]) : __builtin_amdgcn_sdot4((int)__builtin_amdgcn_perm(t2_, t0_, 0x07060302u), (int)wq_[q_], o_[4 * c_ + 1], false); \
                o_[4 * c_ + 2] = (q_ == 0) ? dot4_first(__builtin_amdgcn_perm(t3_, t1_, 0x05040100u), wq_[q_]) : __builtin_amdgcn_sdot4((int)__builtin_amdgcn_perm(t3_, t1_, 0x05040100u), (int)wq_[q_], o_[4 * c_ + 2], false); \
                o_[4 * c_ + 3] = (q_ == 0) ? dot4_first(__builtin_amdgcn_perm(t3_, t1_, 0x07060302u), wq_[q_]) : __builtin_amdgcn_sdot4((int)__builtin_amdgcn_perm(t3_, t1_, 0x07060302u), (int)wq_[q_], o_[4 * c_ + 3], false); } \
              \
            int r8_[8], r4_[4], r2_[2]; \
            _Pragma("unroll") for (int k_ = 0; k_ < 8; ++k_) { unsigned a_ = (unsigned)o_[k_], b_ = (unsigned)o_[k_ + 8]; swap32(a_, b_); r8_[k_] = (int)(a_ + b_); } \
            _Pragma("unroll") for (int k_ = 0; k_ < 4; ++k_) { unsigned a_ = (unsigned)r8_[k_], b_ = (unsigned)r8_[k_ + 4]; swap16(a_, b_); r4_[k_] = (int)(a_ + b_); } \
            _Pragma("unroll") for (int k_ = 0; k_ < 2; ++k_) { const int snd_ = b3 ? r4_[k_] : r4_[k_ + 2], kp_ = b3 ? r4_[k_ + 2] : r4_[k_]; r2_[k_] = kp_ + dpp_i<DPP_ROR8>(snd_); } \
            const int d_ = (sl) * 128 + j8 * 16 + 2 * g8; float* xp_ = X + (row0 + tk_) * DM + d_; const float c_ = SWS[tk_] * vscale; \
            f32x2_t xv_ = xpre; xv_.x += g2pre.x * (c_ * (float)r2_[0]); xv_.y += g2pre.y * (c_ * (float)r2_[1]); *(f32x2_t*)xp_ = xv_; __hip_atomic_fetch_add(SSQL + (ti) * 64, vscale * (xv_.x * xv_.x + xv_.y * xv_.y), __ATOMIC_RELAXED, __HIP_MEMORY_SCOPE_WORKGROUP); } while (0)
#define PEER_XPRE(xd, gd, sl, ti) do { const int d_ = (sl) * 128 + j8 * 16 + 2 * g8; xd = *(const f32x2_t*)(X + (row0 + wave + 8 * (ti)) * DM + d_); } while (0)
        LAS float* SSQL = (LAS float*)(lds + H8_OFF) + wave * 512 + lane;
#pragma unroll
        for (int ti = 0; ti < 8; ++ti) SSQL[ti * 64] = 0.f;
        f32x2_t xpA, xpB, g2A; const f32x2_t& g2B = g2A;
#pragma unroll 1
        for (int vrep = 0; vrep < VREP; ++vrep) {
        const float vscale = (vrep == VREP - 1) ? xscale : 0.f;
        PEER_ISSUE(bufA, V8, 0, 0); PEER_XPRE(xpA, g2A, 0, 0);
#pragma unroll 1
        for (int sl = 0; sl < ((GATHER_PARTS & 2) ? 8 : 0); ++sl) {
            g2A = *(const f32x2_t*)(mb + 5120 + sl * 128 + j8 * 16 + 2 * g8);
            if (STAG_V > 0 && wave >= 4) __builtin_amdgcn_s_sleep(STAG_V);
            PEER_ISSUE(bufB, V8, sl, 1); PEER_XPRE(xpB, g2B, sl, 1); PEER_VCOMP(bufA, xpA, g2A, sl, 0);
            PEER_ISSUE(bufA, V8, sl, 2); PEER_XPRE(xpA, g2A, sl, 2); PEER_VCOMP(bufB, xpB, g2B, sl, 1);
            PEER_ISSUE(bufB, V8, sl, 3); PEER_XPRE(xpB, g2B, sl, 3); PEER_VCOMP(bufA, xpA, g2A, sl, 2);
            PEER_ISSUE(bufA, V8, sl, 4); PEER_XPRE(xpA, g2A, sl, 4); PEER_VCOMP(bufB, xpB, g2B, sl, 3);
            PEER_ISSUE(bufB, V8, sl, 5); PEER_XPRE(xpB, g2B, sl, 5); PEER_VCOMP(bufA, xpA, g2A, sl, 4);
            PEER_ISSUE(bufA, V8, sl, 6); PEER_XPRE(xpA, g2A, sl, 6); PEER_VCOMP(bufB, xpB, g2B, sl, 5);
            PEER_ISSUE(bufB, V8, sl, 7); PEER_XPRE(xpB, g2B, sl, 7); PEER_VCOMP(bufA, xpA, g2A, sl, 6);
            if (sl < 7) { PEER_ISSUE(bufA, V8, sl + 1, 0); PEER_XPRE(xpA, g2A, sl + 1, 0); }
            PEER_VCOMP(bufB, xpB, g2B, sl, 7);
            __builtin_amdgcn_s_barrier();
        }
        if (VREP > 1) { asm volatile("s_waitcnt vmcnt(0)" ::: "memory"); }
        }
        __builtin_amdgcn_s_setprio(0);
#undef PEER_ISSUE
#undef PEER_UCOMP
#undef PEER_VCOMP
#undef PEER_XPRE
        if (n1g_next) {
            asm volatile("s_waitcnt vmcnt(0)" ::: "memory"); __builtin_amdgcn_fence(__ATOMIC_ACQ_REL, "workgroup");
            const float* mn = mod_next + (size_t)b * NMOD;
            f32x4 gg[4], shv[4];
#pragma unroll
            for (int q = 0; q < 4; ++q) { const int k = 256 * q + 4 * lane; gg[q] = *(const f32x4*)(n1g_next + k) * (1.f + *(const f32x4*)(mn + 1024 + k)); shv[q] = *(const f32x4*)(mn + k); }
#pragma unroll
            for (int tq = 0; tq < 2; ++tq) {
                f32x4 xa[4][4];
#pragma unroll
                for (int i = 0; i < 4; ++i)
#pragma unroll
                    for (int q = 0; q < 4; ++q) xa[i][q] = *(const f32x4*)(X + (row0 + wave + 8 * (4 * tq + i)) * DM + 256 * q + 4 * lane);
#pragma unroll
                for (int i = 0; i < 4; ++i) {
                    const int tk = wave + 8 * (4 * tq + i); bf16* hr = H + (row0 + tk) * DM;
                    const float rs2 = rsqrtf(wave_sum(SSQL[(4 * tq + i) * 64]) * (1.f / DM) + RMS_EPS);
#pragma unroll
                    for (int q = 0; q < 4; ++q) { const f32x4 h = xa[i][q] * rs2 * gg[q] + shv[q]; v2u w; w.x = pk2(h.x, h.y); w.y = pk2(h.z, h.w); *(v2u*)(hr + 256 * q + 4 * lane) = w; }
                }
            }
        }
        }
        __syncthreads();
    }
}

#ifndef REP_MASK
#define REP_MASK 0
#endif
constexpr int ppl_count() { int n = 0; for (int s = 0; s < 6; ++s) if (s != 3) n += 1 + ((REP_MASK >> s) & 1); return n; }
constexpr unsigned long long seq_pack() { unsigned long long p = 0; int j = 0; for (int s = 0; s < 6; ++s) if (s != 3) for (int r = 0; r < 1 + ((REP_MASK >> s) & 1); ++r) { p |= (unsigned long long)s << (4 * j); ++j; } return p; }
constexpr int PPL = ppl_count();
constexpr unsigned long long SEQ_PACK = seq_pack();
#ifndef P0_REP
#define P0_REP 1
#endif
#ifndef BAR_REP
#define BAR_REP 1
#endif
#ifndef P0C_REP
#define P0C_REP 1
#endif
constexpr int NPRE = P0_REP + P0C_REP;
constexpr int NPH = NPRE + PPL * DEPTH;
#ifndef PH_MASK
#define PH_MASK 127
#endif
struct Args { const float* in[18]; float* out; unsigned char* ws; int ph_lo, ph_hi; };
__global__ void __launch_bounds__(NWAVES * 64, 2) trunk_fwd(Args args) {
    extern __shared__ __attribute__((aligned(16))) unsigned char lds_raw[];
    LAS unsigned char* lds = (LAS unsigned char*)lds_raw;
    const int tid0 = threadIdx.x;
    const int G = gridDim.x, bid0 = blockIdx.x;
    volatile LAS unsigned* MISC = (volatile LAS unsigned*)(lds + MISC_OFF);
    for (int u = tid0; u < (LDS_BYTES - MISC_OFF) / 4; u += NWAVES * 64) ((LAS unsigned*)(lds + MISC_OFF))[u] = 0u;
    __syncthreads();
    const int lo = args.ph_lo, hi_ph = args.ph_hi;
    XcdBarrier bar; bar.bar = (unsigned*)(args.ws + WS_CTL) + CW_BAR; bar.x = 0; bar.st = nullptr;
    if (hi_ph - lo > 1) bar = xcd_barrier_post((unsigned*)(args.ws + WS_CTL) + CW_BAR, MISC + 8);

    for (int ph = lo; ph < hi_ph; ++ph) {
        int tid = tid0; asm volatile("" : "+v"(tid));
#define RELAUNDER() do { asm volatile("" : "+v"(tid)); } while (0)
        int bid = bid0; asm volatile("" : "+s"(bid));
        size_t wsoff = 0; asm volatile("" : "+s"(wsoff)); unsigned char* ws = args.ws + wsoff;
        const int vcu = (G % 8 == 0) ? (bid % 8) * (G / 8) + bid / 8 : bid;
        float* MOD = (float*)(ws + WS_MOD);
        bf16* WIN = (bf16*)(ws + WS_WIN); bf16* WOUT = (bf16*)(ws + WS_WOUT); bf16* WQ = (bf16*)(ws + WS_WQ); bf16* POOLW = (bf16*)(ws + WS_POOLW); bf16* SUBK = (bf16*)(ws + WS_SUBK);
        bf16* H = (bf16*)(ws + WS_H); bf16* PROJ = (bf16*)(ws + WS_PROJ); bf16* Y = (bf16*)(ws + WS_Y); bf16* QP = (bf16*)(ws + WS_QP);
        float* GG2 = (float*)(ws + WS_GG2); float* SHQ = (float*)(ws + WS_SHQ); float* SS = (float*)(ws + WS_SS);
        unsigned char* U8 = ws + WS_U8; unsigned char* V8 = ws + WS_V8; float* SU = (float*)(ws + WS_SU); float* SV = (float*)(ws + WS_SV);
        float* X = args.out;
        const int NGW = G * NWAVES;
#define LANE_WAVE() RELAUNDER(); const int lane = tid & 63, wave = __builtin_amdgcn_readfirstlane(tid >> 6); const int gw = vcu * NWAVES + wave; (void)lane; (void)gw
        if (ph < P0_REP && (PH_MASK & 1)) {
            LANE_WAVE();
            phase_mod(lds, args.in[1], args.in[2], args.in[3], MOD, tid, bid, G);
            LAS float* scr = (LAS float*)(lds + wave * 16384);
            constexpr int I_IN = 16 * 40, I_OUT = 16 * 32, I_WQ = 16 * 64, I_L = I_IN + I_OUT + I_WQ, I_POOL = 16 * 8;
            for (int it = gw; it < DEPTH * I_L + I_POOL; it += NGW) {
                if (it < DEPTH * I_L) {
                    const int l = it / I_L; int r = it - l * I_L;
                    if (r < I_IN) p0_transpose_item(args.in[6] + (size_t)l * DM * INW, DM, INW, WIN + (size_t)l * INW * DM, scr, r, lane);
                    else if (r < I_IN + I_OUT) p0_transpose_item(args.in[13] + (size_t)l * DM * DM, DM, DM, WOUT + (size_t)l * DM * DM, scr, r - I_IN, lane);
                    else p0_transpose_item(args.in[14] + (size_t)l * DM * 2048, DM, 2048, WQ + (size_t)l * 2048 * DM, scr, r - I_IN - I_OUT, lane);
                } else {
                    const int r = it - DEPTH * I_L, lg = r >> 3;
                    p0_transpose_item(args.in[7] + (size_t)lg * 128 * 128, 128, 128, POOLW + (size_t)lg * 128 * 128, scr, r & 7, lane);
                }
            }
            const size_t gt = (size_t)bid * 512 + tid, GT = (size_t)G * 512;
            cvt_stream(args.in[15], SUBK, (size_t)DEPTH * 2 * 128 * 128 / 8, gt, GT);
            quant_rows<0>(args.in[16], U8, SU, 0, NEXP, gw, NGW, lane);
            quant_rows<0>(args.in[17], V8, SV, 0, NEXP, gw, NGW, lane);
            if (G != 256) { quant_rows<0>(args.in[16], U8, SU, NEXP, DEPTH * NEXP, gw, NGW, lane); quant_rows<0>(args.in[17], V8, SV, NEXP, DEPTH * NEXP, gw, NGW, lane); }
        } else if (ph < NPRE && (PH_MASK & 2)) {
            LANE_WAVE();
            norm_rows_phase(args.in[0], args.in[4], MOD, 0, 1024, H, gw, NGW, lane);
            for (int i = bid * 512 + tid; i < DEPTH * 8 * DM; i += G * 512) { const int k = i & (DM - 1), lb = i >> 10; GG2[i] = args.in[5][(lb >> 3) * DM + k] * (1.f + MOD[(size_t)lb * NMOD + 4096 + k]); }
            for (int it = gw; it < DEPTH * 2048; it += NGW) {
                const int l = it >> 11, n = it & 2047; const bf16* wr_ = WQ + ((size_t)l * 2048 + n) * DM + 16 * lane;
                float wf[16]; { float f8[8]; unpack8(*(const v4u*)wr_, f8);
#pragma unroll
                    for (int k = 0; k < 8; ++k) wf[k] = f8[k];
                    unpack8(*(const v4u*)(wr_ + 8), f8);
#pragma unroll
                    for (int k = 0; k < 8; ++k) wf[8 + k] = f8[k]; }
                float sb[8];
#pragma unroll
                for (int b = 0; b < 8; ++b) { const float* sp = MOD + ((size_t)l * 8 + b) * NMOD + 3072 + 16 * lane; float s = 0.f;
#pragma unroll
                    for (int q4 = 0; q4 < 4; ++q4) { const f32x4 sv = *(const f32x4*)(sp + 4 * q4); s += (sv.x * wf[4 * q4] + sv.y * wf[4 * q4 + 1]) + (sv.z * wf[4 * q4 + 2] + sv.w * wf[4 * q4 + 3]); }
                    sb[b] = s; }
#pragma unroll
                for (int b = 0; b < 8; ++b) { const float s = wave_sum(sb[b]); if (lane == 0) SHQ[((size_t)l * 8 + b) * 2048 + n] = s; }
            }
        } else {
            const int l = (ph - NPRE) / PPL, sub = (int)((SEQ_PACK >> (4 * ((ph - NPRE) - PPL * l))) & 15ull);
            const float* modl = MOD + (size_t)l * 8 * NMOD;
            const int jn = (ph - NPRE) - PPL * l + 1; const float peer_scale = (jn < PPL && (int)((SEQ_PACK >> (4 * jn)) & 15ull) == 5) ? 0.f : 1.f;
            const float gemm2_scale = (sub == 2 && jn < PPL && (int)((SEQ_PACK >> (4 * jn)) & 15ull) == 2) ? 0.f : 1.f;
            if (sub == 0 && (PH_MASK & 4)) {
                RELAUNDER();
                pg8::Gemm g{H, WIN + (size_t)l * INW * DM, T, INW, DM}; pg8::StaticOrder S; S.init(T, INW, G, bid);
                pg8::EpiBf16<0> E{PROJ, INW, nullptr, 0, 0, 1.f};
                pg8::gemm_phase<pg8::EpiBf16<0>, pg8::StaticOrder, true, true>(lds, g, S, E, tid);
                if (G == 256 && bid >= 64 && l + 1 < DEPTH) {
                    const int wave2 = __builtin_amdgcn_readfirstlane(tid >> 6), gw2 = (bid - 64) * NWAVES + wave2, NGW2 = (G - 64) * NWAVES;
                    quant_rows<0>(args.in[16], U8, SU, (l + 1) * NEXP, (l + 2) * NEXP, gw2, NGW2, tid & 63);
                    quant_rows<0>(args.in[17], V8, SV, (l + 1) * NEXP, (l + 2) * NEXP, gw2, NGW2, tid & 63);
                }
            } else if (sub == 4 && (PH_MASK & 4)) {
                RELAUNDER();
                pg8::Gemm g{H, WQ + (size_t)l * 2048 * DM, T, 2048, DM}; pg8::StaticOrder S; S.init(T, 2048, G, bid);
                pg8::EpiBf16RS E{QP, 2048, SS, SHQ + (size_t)l * 8 * 2048};
                pg8::gemm_phase<pg8::EpiBf16RS, pg8::StaticOrder, true, true>(lds, g, S, E, tid);
            } else if (sub == 1 && (PH_MASK & 8)) {
                RELAUNDER();
                phase_mix(lds, PROJ, POOLW + (size_t)l * 4 * 128 * 128, args.in[8] + l * 512, args.in[9] + l * 64, args.in[10] + l * 64, args.in[11] + l * 8, args.in[12] + l * DM, Y, tid, vcu, G);
            } else if (sub == 2 && (PH_MASK & 16)) {
                RELAUNDER();
                pg8::Gemm g{Y, WOUT + (size_t)l * DM * DM, T, DM, DM}; pg8::StaticOrder S; S.init(T, DM, G, bid);
                if (G == 256) { pg8::EpiRes2 E{l == 0 ? args.in[0] : X, X, modl + 2048, GG2 + (size_t)l * 8 * DM, H, SS, gemm2_scale};
                    pg8::gemm_phase<pg8::EpiRes2, pg8::StaticOrder, false, true>(lds, g, S, E, tid); }
            } else if (sub == 3 && (PH_MASK & 32)) {
                LANE_WAVE();
                norm_rows_phase(X, args.in[5] + l * DM, modl, 3072, 4096, H, gw, NGW, lane);
            } else if (PH_MASK & 64) {
                RELAUNDER();
                phase_peer(lds, QP, SUBK + (size_t)l * 2 * 128 * 128, U8 + (size_t)l * NEXP * DM, V8 + (size_t)l * NEXP * DM, SU + (size_t)l * NEXP, SV + (size_t)l * NEXP, X, modl, args.in[5] + l * DM,
                           (l + 1 < DEPTH) ? args.in[4] + (l + 1) * DM : nullptr, MOD + (size_t)(l + 1 < DEPTH ? l + 1 : l) * 8 * NMOD, H, tid, bid, G, peer_scale);
            }
        }
        if (ph + 1 < hi_ph) { xcd_barrier(bar); for (int br = 1; br < BAR_REP; ++br) xcd_barrier(bar); }
    }
}

extern "C" void kernel_launch(void* const* d_in, const int* in_sizes, int n_in, void* d_out, int out_size, void* d_ws, size_t ws_size, hipStream_t stream) {
    static int grid = 0;
    if (grid == 0) {
        if (n_in != 18 || out_size != T * DM || ws_size < WS_END) { fprintf(stderr, "kernel_launch: unexpected shapes (n_in %d, out %d, ws %zu); nothing launched\n", n_in, out_size, ws_size); grid = -1; return; }
        int dev = 0, cus = 0, per_cu = 0;
        if (hipGetDevice(&dev) != hipSuccess || hipDeviceGetAttribute(&cus, hipDeviceAttributeMultiprocessorCount, dev) != hipSuccess) { fprintf(stderr, "kernel_launch: device query failed\n"); grid = -1; return; }
        if (hipFuncSetAttribute((const void*)trunk_fwd, hipFuncAttributeMaxDynamicSharedMemorySize, LDS_BYTES) != hipSuccess) { fprintf(stderr, "kernel_launch: hipFuncSetAttribute failed\n"); grid = -1; return; }
        if (hipOccupancyMaxActiveBlocksPerMultiprocessor(&per_cu, (const void*)trunk_fwd, NWAVES * 64, LDS_BYTES) != hipSuccess || per_cu < 1)
            fprintf(stderr, "kernel_launch: note: occupancy query reports %d workgroups per CU\n", per_cu);
        (void)hipGetLastError();
        grid = cus;
    }
    if (grid < 0) return;
    if (hipMemsetAsync((char*)d_ws + WS_CTL, 0, CTL_ZERO_BYTES, stream) != hipSuccess) { fprintf(stderr, "kernel_launch: memset failed\n"); return; }
    Args a{};
    for (int i = 0; i < 18; ++i) a.in[i] = (const float*)d_in[i];
    a.out = (float*)d_out; a.ws = (unsigned char*)d_ws;
#if MK_PER_PHASE
    for (int ph = 0; ph < NPH; ++ph) { a.ph_lo = ph; a.ph_hi = ph + 1; hipLaunchKernelGGL(trunk_fwd, dim3(grid), dim3(NWAVES * 64), LDS_BYTES, stream, a); }
#else
    a.ph_lo = 0; a.ph_hi = NPH;
    hipLaunchKernelGGL(trunk_fwd, dim3(grid), dim3(NWAVES * 64), LDS_BYTES, stream, a);
#endif
    const hipError_t le = hipPeekAtLastError();
    if (le != hipSuccess) fprintf(stderr, "kernel_launch: launch failed: %s\n", hipGetErrorName(le));
}
```

```cpp
#include <hip/hip_runtime.h>
#include <hip/hip_bf16.h>
#include <cstdio>
#include <cstdint>
#include <cmath>
namespace pg8 {
#define PG8_LAS __attribute__((address_space(3)))
typedef unsigned short bf16_t;
typedef short bf16x8 __attribute__((ext_vector_type(8)));
typedef float f32x4 __attribute__((ext_vector_type(4)));
typedef unsigned u32x4 __attribute__((ext_vector_type(4)));
constexpr int BM = 256, BK = 64, HALF = 128, HTB = HALF * BK * 2  , STAGE_BYTES = 8 * HTB, NXCD = 8, WGM = 8;

__host__ __device__ __forceinline__ int lds_byte(int r, int c) { const int st = (r >> 4) * 2 + (c >> 5), rr = r & 15, cc = c & 31, ob = rr * 64 + cc * 2; return st * 1024 + (ob ^ (((ob >> 9) & 1) << 5)); }
__host__ __device__ __forceinline__ void stage_rc(int b, int& R, int& C) { const int st = b / 1024, sb = b % 1024, swz = sb ^ (((sb >> 9) & 1) << 5); R = (st >> 1) * 16 + swz / 64; C = (st & 1) * 32 + (swz % 64) / 2; }
__host__ __device__ __forceinline__ int perm32(int rho) { const int n = rho >> 4, i = rho & 15; return 8 * (i >> 2) + 4 * n + (i & 3); }

struct Unit { int pm, pn; };
struct Gemm { const bf16_t* A; const bf16_t* Bt; int M, N, K; };

struct StaticOrder {
    int nM, nN, nwg, G, c;
    __host__ __device__ void init(int M, int N, int G_, int c_) { nM = M / BM; nN = N / BM; nwg = nM * nN; G = G_; c = c_; }
    __host__ __device__ bool next(int i, Unit& u) const {
        const long L = (long)i * G + c; if (L >= nwg) return false;
        int wgid = (int)L; { const int q = nwg / NXCD, r = nwg % NXCD, xcd = wgid % NXCD, off = wgid / NXCD; wgid = (xcd < r ? xcd * (q + 1) : r * (q + 1) + (xcd - r) * q) + off; }
        const int nig = WGM * nN, gid = wgid / nig, fm = gid * WGM, gsz = (nM - fm) < WGM ? (nM - fm) : WGM;
        u.pm = fm + ((wgid % nig) % gsz); u.pn = (wgid % nig) / gsz; return true;
    }
    __device__ __forceinline__ void a_ready(const Unit&) const {}
    __device__ __forceinline__ void done(const Unit&) const {}
};

__device__ __forceinline__ unsigned cvt_pk_bf16(float lo, float hi) { unsigned r; asm volatile("v_cvt_pk_bf16_f32 %0, %1, %2" : "=v"(r) : "v"(lo), "v"(hi)); return r; }
typedef float f32x2 __attribute__((ext_vector_type(2)));
__device__ __forceinline__ f32x2 gelu_pk(f32x2 v) {
    const f32x2 av = __builtin_elementwise_abs(v), d = av * 0.2316418882f + 1.0f;
    f32x2 t; t.x = __builtin_amdgcn_rcpf(d.x); t.y = __builtin_amdgcn_rcpf(d.y);
    f32x2 q = t * 0.5307027145f + (-0.7265760135f); q = q * t + 0.7107068705f; q = q * t + (-0.142248368f); q = q * t + 0.127414796f; q = q * t;
    const f32x2 s = (v * v) * (-0.72134752044f);
    f32x2 e; e.x = __builtin_amdgcn_exp2f(s.x); e.y = __builtin_amdgcn_exp2f(s.y);
    const f32x2 m = v * (q * e), r = v - m;
    f32x2 o; o.x = v.x < 0.f ? m.x : r.x; o.y = v.y < 0.f ? m.y : r.y; return o;
}

template <int ACT  > struct EpiBf16 {
    static constexpr bool PERM = true, AFTER_DRAIN = false; static_assert(ACT == 0 || ACT == 1, "EpiBf16: ACT is 0 (none) or 1 (gelu_pk)");
    bf16_t* O; int ldc; const float* bias; int split_cols; size_t split_stride; float scale0;
    __device__ __forceinline__ void operator()(const f32x4 (&acc)[2][2][4][2], const Unit& u, int wr, int wc, int fr, int fq) const {
        const int row0 = u.pm * BM + wr * 64 + fr; int colt = u.pn * BM; bf16_t* base = O;
        float sc = 1.f; if (split_cols) { const int t = colt / split_cols; base += (size_t)t * split_stride; colt -= t * split_cols; if (t == 0) sc = scale0; }
        const int col0 = colt + wc * 32 + 8 * fq, bcol0 = u.pn * BM + wc * 32 + 8 * fq;
        f32x4 bv[2][2];
#pragma unroll
        for (int bj = 0; bj < 2; ++bj)
#pragma unroll
            for (int n = 0; n < 2; ++n) bv[bj][n] = bias ? *(const f32x4*)(bias + bcol0 + bj * HALF + 4 * n) : (f32x4){0.f, 0.f, 0.f, 0.f};
#pragma unroll
        for (int ai = 0; ai < 2; ++ai)
#pragma unroll
            for (int m = 0; m < 4; ++m) { bf16_t* rowp = base + (size_t)(row0 + ai * HALF + m * 16) * ldc + col0;
#pragma unroll
                for (int bj = 0; bj < 2; ++bj) { f32x4 v0 = acc[ai][bj][m][0] + bv[bj][0], v1 = acc[ai][bj][m][1] + bv[bj][1];
                    if (ACT == 1) { f32x2 a = gelu_pk((f32x2){v0[0], v0[1]}), b = gelu_pk((f32x2){v0[2], v0[3]}), c = gelu_pk((f32x2){v1[0], v1[1]}), d = gelu_pk((f32x2){v1[2], v1[3]});
                        v0 = (f32x4){a.x, a.y, b.x, b.y}; v1 = (f32x4){c.x, c.y, d.x, d.y}; }
                    v0 = v0 * sc; v1 = v1 * sc; u32x4 w; w.x = cvt_pk_bf16(v0[0], v0[1]); w.y = cvt_pk_bf16(v0[2], v0[3]); w.z = cvt_pk_bf16(v1[0], v1[1]); w.w = cvt_pk_bf16(v1[2], v1[3]);
                    *(u32x4*)(rowp + bj * HALF) = w; } }
    }
};
struct EpiRes {
    static constexpr bool PERM = false, AFTER_DRAIN = false;
    const float* xin; float* out; const float* gate;
    __device__ __forceinline__ void operator()(const f32x4 (&acc)[2][2][4][2], const Unit& u, int wr, int wc, int fr, int fq) const {
        const int row0 = u.pm * BM + wr * 64 + fr, col0 = u.pn * BM + wc * 32 + 4 * fq;
        const float* gp = gate + (size_t)(u.pm >> 3) * 6144 + col0;
        f32x4 gv[2][2];
#pragma unroll
        for (int bj = 0; bj < 2; ++bj)
#pragma unroll
            for (int n = 0; n < 2; ++n) gv[bj][n] = *(const f32x4*)(gp + bj * HALF + n * 16);
#pragma unroll
        for (int ai = 0; ai < 2; ++ai)
#pragma unroll
            for (int m = 0; m < 4; ++m) { const size_t off = (size_t)(row0 + ai * HALF + m * 16) * 1024 + col0;
#pragma unroll
                for (int bj = 0; bj < 2; ++bj)
#pragma unroll
                    for (int n = 0; n < 2; ++n) { const f32x4 xv = *(const f32x4*)(xin + off + bj * HALF + n * 16); *(f32x4*)(out + off + bj * HALF + n * 16) = xv + gv[bj][n] * acc[ai][bj][m][n]; } }
    }
};


struct EpiRes2 {
    static constexpr bool PERM = false, AFTER_DRAIN = true;
    const float* xin; float* out; const float* gate; const float* gg2; bf16_t* xg; float* ss; float gscale;
    __device__ __forceinline__ void fused(f32x4 (&acc)[2][2][4][2], const Unit& u, int wr, int wc, int fr, int fq, PG8_LAS unsigned char* lds, int wid, int lane) const {
        constexpr int RS = 1040;
        const int b = u.pm >> 3, colg = u.pn * BM + 4 * lane;
        const f32x4 gv = *(const f32x4*)(gate + (size_t)b * 6144 + colg) * gscale, g2v = *(const f32x4*)(gg2 + (size_t)b * 1024 + colg);
#pragma unroll
        for (int ai = 0; ai < 2; ++ai) {
            if (ai) { asm volatile("s_waitcnt lgkmcnt(0)" ::: "memory"); __builtin_amdgcn_s_barrier(); asm volatile("" ::: "memory"); }
#pragma unroll
            for (int m = 0; m < 4; ++m)
#pragma unroll
                for (int bj = 0; bj < 2; ++bj)
#pragma unroll
                    for (int n = 0; n < 2; ++n) *(PG8_LAS f32x4*)(lds + (wr * 64 + m * 16 + fr) * RS + (bj * HALF + wc * 32 + n * 16 + fq * 4) * 4) = acc[ai][bj][m][n];
            asm volatile("s_waitcnt lgkmcnt(0)" ::: "memory"); __builtin_amdgcn_s_barrier(); asm volatile("" ::: "memory");
#pragma unroll
            for (int hq = 0; hq < 2; ++hq) {
                f32x4 xv[8];
#pragma unroll
                for (int i = 0; i < 8; ++i) { const int row = u.pm * BM + ai * HALF + wid * 16 + hq * 8 + i; xv[i] = *(const f32x4*)(xin + (size_t)row * 1024 + colg); }
#pragma unroll
                for (int i = 0; i < 8; ++i) { const int rl = wid * 16 + hq * 8 + i, row = u.pm * BM + ai * HALF + rl;
                    const f32x4 a = *(const PG8_LAS f32x4*)(lds + rl * RS + lane * 16);
                    const f32x4 x1 = xv[i] + gv * a;
                    *(f32x4*)(out + (size_t)row * 1024 + colg) = x1;
                    float s = (x1[0] * x1[0] + x1[1] * x1[1]) + (x1[2] * x1[2] + x1[3] * x1[3]);
                    const f32x4 gx = x1 * g2v; typedef unsigned u32x2 __attribute__((ext_vector_type(2))); u32x2 w; w.x = cvt_pk_bf16(gx[0], gx[1]); w.y = cvt_pk_bf16(gx[2], gx[3]);
                    *(u32x2*)(xg + (size_t)row * 1024 + colg) = w;
                    s += __int_as_float(__builtin_amdgcn_update_dpp(0, __float_as_int(s), 0xB1, 0xf, 0xf, true)); s += __int_as_float(__builtin_amdgcn_update_dpp(0, __float_as_int(s), 0x4E, 0xf, 0xf, true));
                    s += __int_as_float(__builtin_amdgcn_update_dpp(0, __float_as_int(s), 0x141, 0xf, 0xf, true)); s += __int_as_float(__builtin_amdgcn_update_dpp(0, __float_as_int(s), 0x140, 0xf, 0xf, true));
                    { auto r = __builtin_amdgcn_permlane16_swap(__float_as_uint(s), __float_as_uint(s), false, false); s = __uint_as_float(r[0]) + __uint_as_float(r[1]); }
                    { auto r = __builtin_amdgcn_permlane32_swap(__float_as_uint(s), __float_as_uint(s), false, false); s = __uint_as_float(r[0]) + __uint_as_float(r[1]); }
                    if (lane == 0) ss[(size_t)row * 4 + u.pn] = s; }
            }
        }
    }
};
struct EpiBf16RS {
    static constexpr bool PERM = true, AFTER_DRAIN = false;
    bf16_t* O; int ldc; const float* ss; const float* shq;
    __device__ __forceinline__ void operator()(const f32x4 (&acc)[2][2][4][2], const Unit& u, int wr, int wc, int fr, int fq) const {
        const int row0 = u.pm * BM + wr * 64 + fr, col0 = u.pn * BM + wc * 32 + 8 * fq, b = u.pm >> 3;
        const float* bp = shq + (size_t)b * ldc + col0;
        f32x4 bv[2][2];
#pragma unroll
        for (int bj = 0; bj < 2; ++bj)
#pragma unroll
            for (int n = 0; n < 2; ++n) bv[bj][n] = *(const f32x4*)(bp + bj * HALF + 4 * n);
        f32x4 sp[2][4];
#pragma unroll
        for (int ai = 0; ai < 2; ++ai)
#pragma unroll
            for (int m = 0; m < 4; ++m) sp[ai][m] = *(const f32x4*)(ss + (size_t)(row0 + ai * HALF + m * 16) * 4);
#pragma unroll
        for (int ai = 0; ai < 2; ++ai)
#pragma unroll
            for (int m = 0; m < 4; ++m) { const int row = row0 + ai * HALF + m * 16;
                const float rstd = __builtin_amdgcn_rsqf(((sp[ai][m][0] + sp[ai][m][1]) + (sp[ai][m][2] + sp[ai][m][3])) * (1.0f / 1024.0f) + 1e-6f);
                bf16_t* rowp = O + ((size_t)u.pm * (ldc / BM) + u.pn) * (BM * BM) + (size_t)((ai * 4 + m) * 2) * 4096 + ((wr * 4 + wc) * 64 + fq * 16 + fr) * 8; (void)row; (void)col0;
#pragma unroll
                for (int bj = 0; bj < 2; ++bj) { const f32x4 v0 = acc[ai][bj][m][0] * rstd + bv[bj][0], v1 = acc[ai][bj][m][1] * rstd + bv[bj][1];
                    u32x4 w; w.x = cvt_pk_bf16(v0[0], v0[1]); w.y = cvt_pk_bf16(v0[2], v0[3]); w.z = cvt_pk_bf16(v1[0], v1[1]); w.w = cvt_pk_bf16(v1[2], v1[3]);
                    *(u32x4*)(rowp + bj * 4096) = w; } }
    }
};
template <class Epi, class Sched, bool ALIGN_EPI = false, bool SP2 = false>
__device__ __forceinline__ void gemm_phase(PG8_LAS unsigned char* lds, const Gemm g, const Sched& S, const Epi& E, const int tid) {
    const int wid = __builtin_amdgcn_readfirstlane(tid >> 6), lane = tid & 63, wr = wid >> 2, wc = wid & 3, fr = lane & 15, fq = lane >> 4;
    const int K = g.K, nt = K / BK;
    unsigned voffA[2], voffB[2];
#pragma unroll
    for (int i = 0; i < 2; ++i) { int R, C; stage_rc(tid * 16 + i * 8192, R, C); const int Rb = Epi::PERM ? ((R & ~31) + perm32(R & 31)) : R;
        voffA[i] = (unsigned)(R * K + C) * 2u; voffB[i] = (unsigned)(Rb * K + C) * 2u; }
    const size_t kstep = (size_t)(BK * 2);
    const size_t hstep = (size_t)HALF * K * 2;
    const size_t tstep = 2 * hstep;
    const unsigned ldsw = (unsigned)wid * 1024u;
    const int aoff = lds_byte(wr * 64 + fr, fq * 8), boff = lds_byte(wc * 32 + fr, fq * 8);
#define PG8_SA(b, h) (((b) * 2 + (h)) * HTB)
#define PG8_SB(b, h) ((4 + (b) * 2 + (h)) * HTB)
#define PG8_STAGE(bufoff, gbase, voff) do { _Pragma("unroll") for (int _i = 0; _i < 2; ++_i) \
        __builtin_amdgcn_global_load_lds((const unsigned*)((const char*)(gbase) + (voff)[_i]), (PG8_LAS unsigned*)(lds + (bufoff) + ldsw + _i * 8192), 16, 0, 0); } while (0)
#define PG8_LDA(dst, b, h) do { _Pragma("unroll") for (int m = 0; m < 4; ++m) _Pragma("unroll") for (int k = 0; k < 2; ++k) dst[m][k] = *(const PG8_LAS bf16x8*)(lds + PG8_SA(b, h) + aoff + m * 2048 + k * 1024); } while (0)
#define PG8_LDB(dst, b, h) do { _Pragma("unroll") for (int n = 0; n < 2; ++n) _Pragma("unroll") for (int k = 0; k < 2; ++k) dst[n][k] = *(const PG8_LAS bf16x8*)(lds + PG8_SB(b, h) + boff + n * 2048 + k * 1024); } while (0)
#define PG8_MMA(ai, bj, At, Bt) do { __builtin_amdgcn_s_setprio(1); _Pragma("unroll") for (int m = 0; m < 4; ++m) _Pragma("unroll") for (int n = 0; n < 2; ++n) _Pragma("unroll") for (int k = 0; k < 2; ++k) \
        acc[ai][bj][m][n] = __builtin_amdgcn_mfma_f32_16x16x32_bf16(Bt[n][k], At[m][k], acc[ai][bj][m][n], 0, 0, 0); __builtin_amdgcn_s_setprio(0); } while (0)
#define PG8_WAIT_V(n) asm volatile("s_waitcnt vmcnt(" #n ")" ::: "memory")
#define PG8_WAIT_L(n) asm volatile("s_waitcnt lgkmcnt(" #n ")" ::: "memory")
#define PG8_BAR __builtin_amdgcn_s_barrier()
#define PG8_SCHED __builtin_amdgcn_sched_barrier(0)
    Unit cur, nxt; int ui = 0;
    if (!S.next(0, cur)) return;
    f32x4 acc[2][2][4][2];
#pragma unroll
    for (int a = 0; a < 2; ++a)
#pragma unroll
        for (int b = 0; b < 2; ++b)
#pragma unroll
            for (int m = 0; m < 4; ++m)
#pragma unroll
                for (int n = 0; n < 2; ++n) acc[a][b][m][n] = (f32x4){0.f, 0.f, 0.f, 0.f};
    bf16x8 At[4][2], B0[2][2], B1[2][2];
    const char* cA = (const char*)g.A + (size_t)cur.pm * tstep; const char* cB = (const char*)g.Bt + (size_t)cur.pn * tstep;
    S.a_ready(cur);
    if constexpr (SP2) {
        PG8_STAGE(PG8_SB(0, 0), cB, voffB); PG8_STAGE(PG8_SB(0, 1), cB + hstep, voffB); PG8_STAGE(PG8_SA(0, 0), cA, voffA); PG8_STAGE(PG8_SA(0, 1), cA + hstep, voffA);
        if (wr == 1) PG8_BAR;
        PG8_WAIT_V(2); PG8_BAR;
        PG8_STAGE(PG8_SB(1, 0), cB + kstep, voffB); PG8_STAGE(PG8_SA(1, 0), cA + kstep, voffA); PG8_STAGE(PG8_SB(1, 1), cB + hstep + kstep, voffB);
        PG8_WAIT_V(6); PG8_BAR;
    } else {
        PG8_STAGE(PG8_SB(0, 0), cB, voffB); PG8_STAGE(PG8_SA(0, 0), cA, voffA); PG8_STAGE(PG8_SB(0, 1), cB + hstep, voffB); PG8_STAGE(PG8_SA(0, 1), cA + hstep, voffA);
        if (wr == 1) PG8_BAR;
        PG8_WAIT_V(4); PG8_BAR;
        PG8_STAGE(PG8_SB(1, 0), cB + kstep, voffB); PG8_STAGE(PG8_SA(1, 0), cA + kstep, voffA); PG8_STAGE(PG8_SB(1, 1), cB + hstep + kstep, voffB);
        PG8_WAIT_V(6); PG8_BAR;
    }
    for (;;) {
        const bool has_next = S.next(ui + 1, nxt);
        const char* nA = has_next ? (const char*)g.A + (size_t)nxt.pm * tstep : cA; const char* nB = has_next ? (const char*)g.Bt + (size_t)nxt.pn * tstep : cB;
        for (int t = 0; t < nt; t += 2) {
            const bool last = (t == nt - 2);
            const char* a1 = cA + (size_t)(t + 1) * kstep;
            const char* a2 = last ? nA : cA + (size_t)(t + 2) * kstep; const char* b2 = last ? nB : cB + (size_t)(t + 2) * kstep;
            const char* a3 = a2 + kstep; const char* b3 = b2 + kstep;
            if (last && has_next) S.a_ready(nxt);
            if constexpr (SP2) {
            PG8_LDB(B0, 0, 0); PG8_LDB(B1, 0, 1); PG8_SCHED; PG8_LDA(At, 0, 0); PG8_STAGE(PG8_SA(1, 1), a1 + hstep, voffA);
            PG8_WAIT_V(8); PG8_WAIT_L(0); PG8_BAR; PG8_MMA(0, 0, At, B0); PG8_MMA(0, 1, At, B1); PG8_BAR; PG8_SCHED;
            PG8_LDA(At, 0, 1); PG8_STAGE(PG8_SB(0, 0), b2, voffB); PG8_STAGE(PG8_SB(0, 1), b2 + hstep, voffB); PG8_STAGE(PG8_SA(0, 0), a2, voffA);
            PG8_WAIT_V(8); PG8_WAIT_L(0); PG8_BAR; PG8_MMA(1, 0, At, B0); PG8_MMA(1, 1, At, B1); PG8_BAR; PG8_SCHED;
            PG8_LDB(B0, 1, 0); PG8_LDB(B1, 1, 1); PG8_SCHED; PG8_LDA(At, 1, 0); PG8_STAGE(PG8_SA(0, 1), a2 + hstep, voffA);
            PG8_WAIT_V(8); PG8_WAIT_L(0); PG8_BAR; PG8_MMA(0, 0, At, B0); PG8_MMA(0, 1, At, B1); PG8_BAR; PG8_SCHED;
            PG8_LDA(At, 1, 1); PG8_STAGE(PG8_SB(1, 0), b3, voffB); PG8_STAGE(PG8_SB(1, 1), b3 + hstep, voffB); PG8_STAGE(PG8_SA(1, 0), a3, voffA);
            PG8_WAIT_V(8); PG8_WAIT_L(0); PG8_BAR; PG8_MMA(1, 0, At, B0); PG8_MMA(1, 1, At, B1); PG8_BAR; PG8_SCHED;
            } else {
            PG8_LDB(B0, 0, 0); PG8_SCHED; PG8_LDA(At, 0, 0); PG8_STAGE(PG8_SA(1, 1), a1 + hstep, voffA);
            PG8_WAIT_L(8); PG8_BAR; PG8_WAIT_L(0); PG8_MMA(0, 0, At, B0); PG8_BAR; PG8_SCHED;
            PG8_LDB(B1, 0, 1); PG8_STAGE(PG8_SB(0, 0), b2, voffB);
            PG8_BAR; PG8_WAIT_L(0); PG8_MMA(0, 1, At, B1); PG8_BAR;
            PG8_LDA(At, 0, 1); PG8_STAGE(PG8_SA(0, 0), a2, voffA);
            PG8_BAR; PG8_WAIT_L(0); PG8_MMA(1, 0, At, B0); PG8_BAR; PG8_SCHED;
            PG8_STAGE(PG8_SB(0, 1), b2 + hstep, voffB);
            PG8_WAIT_V(6); PG8_BAR; PG8_MMA(1, 1, At, B1); PG8_BAR;
            PG8_LDB(B0, 1, 0); PG8_SCHED; PG8_LDA(At, 1, 0); PG8_STAGE(PG8_SA(0, 1), a2 + hstep, voffA);
            PG8_WAIT_L(8); PG8_BAR; PG8_WAIT_L(0); PG8_MMA(0, 0, At, B0); PG8_BAR; PG8_SCHED;
            PG8_LDB(B1, 1, 1); PG8_STAGE(PG8_SB(1, 0), b3, voffB);
            PG8_BAR; PG8_WAIT_L(0); PG8_MMA(0, 1, At, B1); PG8_BAR;
            PG8_LDA(At, 1, 1); PG8_STAGE(PG8_SA(1, 0), a3, voffA);
            PG8_BAR; PG8_WAIT_L(0); PG8_MMA(1, 0, At, B0); PG8_BAR; PG8_SCHED;
            PG8_STAGE(PG8_SB(1, 1), b3 + hstep, voffB);
            PG8_WAIT_V(6); PG8_BAR; PG8_MMA(1, 1, At, B1); PG8_BAR;
            }
        }
        if constexpr (ALIGN_EPI) { if (wr == 0) PG8_BAR; }
        if constexpr (!Epi::AFTER_DRAIN) { E(acc, cur, wr, wc, fr, fq); S.done(cur); }
        if (!has_next) break;
#pragma unroll
        for (int a = 0; a < 2; ++a)
#pragma unroll
            for (int b = 0; b < 2; ++b)
#pragma unroll
                for (int m = 0; m < 4; ++m)
#pragma unroll
                    for (int n = 0; n < 2; ++n) acc[a][b][m][n] = (f32x4){0.f, 0.f, 0.f, 0.f};
        cur = nxt; cA = nA; cB = nB; ++ui;
        if constexpr (ALIGN_EPI) { if (wr == 1) PG8_BAR; }
    }
    PG8_WAIT_V(0);
    if constexpr (!ALIGN_EPI) { if (wr == 0) PG8_BAR; }
    PG8_BAR;
    if constexpr (Epi::AFTER_DRAIN) { E.fused(acc, cur, wr, wc, fr, fq, lds, wid, lane); S.done(cur); }
#undef PG8_SA
#undef PG8_SB
#undef PG8_STAGE
#undef PG8_LDA
#undef PG8_LDB
#undef PG8_MMA
#undef PG8_WAIT_V
#undef PG8_WAIT_L
#undef PG8_BAR
#undef PG8_SCHED
}
}

constexpr int NB = 8, SEQ = 2048, DM = 1024, T = NB * SEQ, DEPTH = 4;
constexpr int INW = 1280, NMOD = 6144, NEXP = 16384;
constexpr float RMS_EPS = 1e-6f, LOG2E = 1.4426950408889634f;
constexpr int NWAVES = 8;
#ifndef MK_PER_PHASE
#define MK_PER_PHASE 0
#endif

constexpr size_t MiB = 1u << 20;
constexpr size_t WS_CTL = 0, CTL_ZERO_BYTES = 1 * MiB;
constexpr size_t WS_MOD = 1 * MiB;
constexpr size_t WS_WIN = 2 * MiB;
constexpr size_t WS_WOUT = 12 * MiB;
constexpr size_t WS_WQ = 20 * MiB;
constexpr size_t WS_POOLW = 36 * MiB;
constexpr size_t WS_SUBK = 37 * MiB;
constexpr size_t WS_H = 38 * MiB;
constexpr size_t WS_PROJ = 70 * MiB;
constexpr size_t WS_Y = 110 * MiB;
constexpr size_t WS_QP = 142 * MiB;
constexpr size_t WS_U8 = 206 * MiB;
constexpr size_t WS_V8 = 270 * MiB;
constexpr size_t WS_SU = 334 * MiB;
constexpr size_t WS_SV = 335 * MiB;
constexpr size_t WS_GG2 = 336 * MiB;
constexpr size_t WS_SHQ = 337 * MiB;
constexpr size_t WS_SS = 338 * MiB;
constexpr size_t WS_END = 340 * MiB;
constexpr int CW_BAR = 4096;
constexpr int CW_RANK = 16384;

constexpr int LDS_BYTES = 150528;
constexpr int MISC_OFF = 148480;

#define GAS __attribute__((address_space(1)))
#define LAS __attribute__((address_space(3)))
typedef unsigned short bf16;
typedef unsigned v4u __attribute__((ext_vector_type(4)));
typedef unsigned v2u __attribute__((ext_vector_type(2)));
typedef float f32x4 __attribute__((ext_vector_type(4)));
typedef float f32x16 __attribute__((ext_vector_type(16)));
typedef short bf16x8 __attribute__((ext_vector_type(8)));
typedef float f32x2_t __attribute__((ext_vector_type(2)));
typedef __bf16 bf16x2_t __attribute__((ext_vector_type(2)));
typedef GAS unsigned gu32;
#define RLX_AGENT __ATOMIC_RELAXED, __HIP_MEMORY_SCOPE_AGENT
#define LDS_WAIT() asm volatile("s_waitcnt lgkmcnt(0)" ::: "memory")
__device__ __forceinline__ unsigned pk2(float lo, float hi) { f32x2_t v = {lo, hi}; bf16x2_t b = __builtin_convertvector(v, bf16x2_t); return __builtin_bit_cast(unsigned, b); }
__device__ __forceinline__ float bflo(unsigned w) { return __uint_as_float(w << 16); }
__device__ __forceinline__ float bfhi(unsigned w) { return __uint_as_float(w & 0xffff0000u); }
__device__ __forceinline__ float dot2_bf16(unsigned w, unsigned x, float acc) { return __builtin_amdgcn_fdot2_f32_bf16(__builtin_bit_cast(bf16x2_t, w), __builtin_bit_cast(bf16x2_t, x), acc, false); }
#define DPP_XOR1 0xB1
#define DPP_XOR2 0x4E
#define DPP_HMIRROR 0x141
#define DPP_MIRROR 0x140
#define DPP_ROR8 0x128
template <int CTRL> __device__ __forceinline__ int dpp_i(int v) { return __builtin_amdgcn_update_dpp(0, v, CTRL, 0xf, 0xf, true); }
template <int CTRL> __device__ __forceinline__ float dpp_f(float v) { return __int_as_float(__builtin_amdgcn_update_dpp(0, __float_as_int(v), CTRL, 0xf, 0xf, true)); }
__device__ __forceinline__ void swap32(unsigned& a, unsigned& b) { auto r = __builtin_amdgcn_permlane32_swap(a, b, false, false); a = r[0]; b = r[1]; }
__device__ __forceinline__ void swap16(unsigned& a, unsigned& b) { auto r = __builtin_amdgcn_permlane16_swap(a, b, false, false); a = r[0]; b = r[1]; }
__device__ __forceinline__ float sum32(float v) { unsigned a = __float_as_uint(v), b = a; swap32(a, b); return __uint_as_float(a) + __uint_as_float(b); }
__device__ __forceinline__ float xchg32(float v, int hi) { unsigned a = __float_as_uint(v), b = a; swap32(a, b); return __uint_as_float(hi ? a : b); }
__device__ __forceinline__ float wave_sum(float v) {
    v += dpp_f<DPP_XOR1>(v); v += dpp_f<DPP_XOR2>(v); v += dpp_f<DPP_HMIRROR>(v); v += dpp_f<DPP_MIRROR>(v);
    { unsigned a = __float_as_uint(v), b = a; swap16(a, b); v = __uint_as_float(a) + __uint_as_float(b); }
    return sum32(v);
}
__device__ __forceinline__ float wave_max(float v) {
    v = fmaxf(v, dpp_f<DPP_XOR1>(v)); v = fmaxf(v, dpp_f<DPP_XOR2>(v)); v = fmaxf(v, dpp_f<DPP_HMIRROR>(v)); v = fmaxf(v, dpp_f<DPP_MIRROR>(v));
    { unsigned a = __float_as_uint(v), b = a; swap16(a, b); v = fmaxf(__uint_as_float(a), __uint_as_float(b)); }
    { unsigned a = __float_as_uint(v), b = a; swap32(a, b); v = fmaxf(__uint_as_float(a), __uint_as_float(b)); }
    return v;
}
__device__ __forceinline__ f32x16 mfma32(bf16x8 a, bf16x8 b, f32x16 c) { return __builtin_amdgcn_mfma_f32_32x32x16_bf16(a, b, c, 0, 0, 0); }
__device__ __forceinline__ f32x16 zero16() { f32x16 z;
#pragma unroll
    for (int i = 0; i < 16; ++i) z[i] = 0.f;
    return z; }
#define XB_TMO      128
#define XB_XCNT(j)  (256  + 64 * (j))
#define XB_XSUB(j)  (1280 + 64 * (j))
#define XB_XGEN(j)  (2304 + 64 * (j))
#define XB_TOP      3328
#define XB_TOPGEN   3392
#define XCD_BAR_WORDS 3456
#define XB_SPIN_CAP (1u << 18)

__device__ __forceinline__ unsigned xb_ld(unsigned* p)              { return __hip_atomic_load(p, __ATOMIC_RELAXED, __HIP_MEMORY_SCOPE_AGENT); }
__device__ __forceinline__ unsigned xb_add(unsigned* p, unsigned v) { return __hip_atomic_fetch_add(p, v, __ATOMIC_RELAXED, __HIP_MEMORY_SCOPE_AGENT); }
__device__ __forceinline__ unsigned xb_xcc_id() { return (unsigned)__builtin_amdgcn_s_getreg((3 << 11) | 20) & 0xFu; }
#define XB_SPIN(cond, bar) do { unsigned _sp = 0; while (cond) { __builtin_amdgcn_s_sleep(1); \
    if ((++_sp & 255u) == 0u) { if (xb_ld(&(bar)[XB_TMO])) break; if (_sp > XB_SPIN_CAP) { atomicAdd(&(bar)[XB_TMO], 1u); break; } } } } while (0)

struct XcdBarrier {
    unsigned* bar; unsigned x;
    volatile LAS unsigned* st;
};

__device__ __forceinline__ XcdBarrier xcd_barrier_post(unsigned* bar, volatile LAS unsigned* st) {
    XcdBarrier b; b.bar = bar; b.x = xb_xcc_id(); b.st = st;
    if (threadIdx.x == 0) (void)xb_add(&bar[XB_XCNT(b.x)], 1u);
    return b;
}
__device__ __forceinline__ void xcd_barrier_complete(unsigned* bar, unsigned x, unsigned& nloc, unsigned& nx) {
    const unsigned G = gridDim.x * gridDim.y * gridDim.z;
    unsigned sum, cnt, mine, sp = 0u;
    for (;;) {
        sum = 0u; cnt = 0u; mine = 0u;
#pragma unroll
        for (unsigned j = 0; j < 16; ++j) { const unsigned c = xb_ld(&bar[XB_XCNT(j)]); sum += c; cnt += (c > 0u) ? 1u : 0u; mine = (j == x) ? c : mine; }
        if (sum == G) break;
        __builtin_amdgcn_s_sleep(1);
        if ((++sp & 255u) == 0u) { if (xb_ld(&bar[XB_TMO])) break; if (sp > XB_SPIN_CAP) { atomicAdd(&bar[XB_TMO], 1u); break; } }
    }
    nloc = mine > 0u ? mine : 1u; nx = cnt > 0u ? cnt : 1u;
}

__device__ __forceinline__ void xcd_barrier(const XcdBarrier& b) {
    asm volatile("s_waitcnt vmcnt(0)" ::: "memory");
    __syncthreads();
    if (threadIdx.x == 0) {
        unsigned* bar = b.bar;
        __builtin_amdgcn_s_waitcnt(0);
        unsigned nloc = b.st[0], nx = b.st[1];
        if (nloc == 0u) { xcd_barrier_complete(bar, b.x, nloc, nx); b.st[0] = nloc; b.st[1] = nx; }
        const unsigned old = xb_add(&bar[XB_XSUB(b.x)], 1u);
        const unsigned gen = old / nloc;
        if (old + 1u == (gen + 1u) * nloc) {
            __builtin_amdgcn_fence(__ATOMIC_RELEASE, "agent");
            asm volatile("s_waitcnt vmcnt(0)" ::: "memory");
            const unsigned og = xb_add(&bar[XB_TOP], 1u);
            const unsigned tg = og / nx;
            if (og + 1u == (tg + 1u) * nx) xb_add(&bar[XB_TOPGEN], 1u);
            else XB_SPIN(xb_ld(&bar[XB_TOPGEN]) == tg, bar);
            __builtin_amdgcn_fence(__ATOMIC_ACQUIRE, "agent");
            xb_add(&bar[XB_XGEN(b.x)], 1u);
            asm volatile("s_waitcnt vmcnt(0)" ::: "memory");
        } else {
            XB_SPIN(xb_ld(&bar[XB_XGEN(b.x)]) == gen, bar);
            __builtin_amdgcn_fence(__ATOMIC_ACQUIRE, "agent");
            asm volatile("s_waitcnt vmcnt(0)" ::: "memory");
        }
    }
    __syncthreads();
}
#ifndef GPRIO
#define GPRIO 1
#endif
__device__ __forceinline__ int dot4_first(unsigned a, unsigned b) { int d; asm("v_dot4_i32_i8 %0, %1, %2, 0" : "=v"(d) : "v"(a), "v"(b)); return d; }
#ifndef STAG_U
#define STAG_U 21
#endif
#ifndef STAG_V
#define STAG_V 29
#endif

constexpr int MODP_KC = 16, MOD_COLS = DEPTH * NMOD;
__device__ __forceinline__ void phase_modp(LAS unsigned char* lds, const float* C, const float* w_ada, float* MODP, int tid, int bid, int G) {
    LAS float* cond = (LAS float*)lds; LAS float* part = (LAS float*)(lds + 32768);
    for (int i = tid; i < 8192; i += 512) { const int b = i >> 10, k = i & 1023; const float c = C[i]; cond[k * 8 + b] = c / (1.f + __expf(-c)); }
    __syncthreads();
    const int cg = tid & 127, ks = tid >> 7;
    for (int item = bid; item < MODP_KC * (MOD_COLS / 512); item += G) {
        const int kc = item & (MODP_KC - 1), cc = item >> 4, k0 = kc * 64 + ks * 16;
        const int col = cc * 512 + cg * 4, l = col / NMOD, n = col - l * NMOD;
        const float* Wl = w_ada + (size_t)l * DM * NMOD + (size_t)k0 * NMOD + n;
        f32x4 w[16];
#pragma unroll
        for (int kk = 0; kk < 16; ++kk) w[kk] = __builtin_nontemporal_load((const f32x4*)(Wl + (size_t)kk * NMOD));
        f32x4 acc[8];
#pragma unroll
        for (int b = 0; b < 8; ++b) acc[b] = (f32x4){0.f, 0.f, 0.f, 0.f};
#pragma unroll
        for (int kk = 0; kk < 16; ++kk) {
            const f32x4 c0 = *(const LAS f32x4*)(cond + (k0 + kk) * 8), c1 = *(const LAS f32x4*)(cond + (k0 + kk) * 8 + 4);
#pragma unroll
            for (int b = 0; b < 4; ++b) { acc[b] += c0[b] * w[kk]; acc[4 + b] += c1[b] * w[kk]; }
        }
#pragma unroll
        for (int b = 0; b < 8; ++b) *(LAS f32x4*)(part + (ks * 8 + b) * 512 + cg * 4) = acc[b];
        __syncthreads();
        for (int o = tid; o < 1024; o += 512) {
            const int b = o >> 7, c4 = o & 127;
            const f32x4 s = (*(const LAS f32x4*)(part + (0 * 8 + b) * 512 + c4 * 4) + *(const LAS f32x4*)(part + (1 * 8 + b) * 512 + c4 * 4)) + (*(const LAS f32x4*)(part + (2 * 8 + b) * 512 + c4 * 4) + *(const LAS f32x4*)(part + (3 * 8 + b) * 512 + c4 * 4));
            *(f32x4*)(MODP + ((size_t)kc * 8 + b) * MOD_COLS + cc * 512 + c4 * 4) = s;
        }
        __syncthreads();
    }
}
__device__ __forceinline__ void mod_reduce(const float* MODP, const float* b_ada, float* MOD, size_t gt, size_t GT) {
    for (size_t i = gt; i < (size_t)8 * MOD_COLS / 4; i += GT) {
        const int b = (int)(i / (MOD_COLS / 4)), col = (int)(i - (size_t)b * (MOD_COLS / 4)) * 4, l = col / NMOD, n = col - l * NMOD;
        f32x4 s = *(const f32x4*)(b_ada + (size_t)l * NMOD + n);
#pragma unroll
        for (int kc = 0; kc < MODP_KC; ++kc) s += *(const f32x4*)(MODP + ((size_t)kc * 8 + b) * MOD_COLS + col);
        *(f32x4*)(MOD + ((size_t)l * 8 + b) * NMOD + n) = s;
    }
}
__device__ __forceinline__ void p0_transpose_item(const float* W, int K, int N, bf16* WT, LAS float* scr, int item, int lane) {
    const int nblk = N / 32, kb = item / nblk, nb = item % nblk, k0 = 64 * kb, n0 = 32 * nb;
#pragma unroll 8
    for (int i = 0; i < 32; ++i) { const int kk = 2 * i + (lane >> 5); scr[kk * 33 + (lane & 31)] = W[(size_t)(k0 + kk) * N + n0 + (lane & 31)]; }
    LDS_WAIT(); asm volatile("" ::: "memory");
    const int c = lane & 7;
#pragma unroll
    for (int j = 0; j < 4; ++j) { const int n = (lane >> 3) + 8 * j; const LAS float* s = scr + (8 * c) * 33 + n;
        v4u o; o.x = pk2(s[0 * 33], s[1 * 33]); o.y = pk2(s[2 * 33], s[3 * 33]); o.z = pk2(s[4 * 33], s[5 * 33]); o.w = pk2(s[6 * 33], s[7 * 33]);
        *(v4u*)(WT + (size_t)(n0 + n) * K + k0 + 8 * c) = o; }
    LDS_WAIT(); asm volatile("" ::: "memory");
}
constexpr int TT_STRIDE = 132;
__device__ __forceinline__ void p0_transpose_tile(const float* W, int K, int N, bf16* WT, LAS float* tile, int titem, int tid) {
    const int nblk = N / 128, kb = titem / nblk, nb = titem - kb * nblk, k0 = 64 * kb, n0 = 128 * nb;
    f32x4 v[4];
#pragma unroll
    for (int i = 0; i < 4; ++i) { const int idx = tid + 512 * i, row = idx >> 5, c4 = idx & 31; v[i] = __builtin_nontemporal_load((const f32x4*)(W + (size_t)(k0 + row) * N + n0 + 4 * c4)); }
#pragma unroll
    for (int i = 0; i < 4; ++i) { const int idx = tid + 512 * i, row = idx >> 5, c4 = idx & 31; *(LAS f32x4*)(tile + row * TT_STRIDE + 4 * c4) = v[i]; }
    __syncthreads();
#pragma unroll
    for (int j = 0; j < 2; ++j) { const int task = tid + 512 * j, kg = task >> 7, n = task & 127; const LAS float* sp = tile + (8 * kg) * TT_STRIDE + n;
        v4u o; o.x = pk2(sp[0 * TT_STRIDE], sp[1 * TT_STRIDE]); o.y = pk2(sp[2 * TT_STRIDE], sp[3 * TT_STRIDE]); o.z = pk2(sp[4 * TT_STRIDE], sp[5 * TT_STRIDE]); o.w = pk2(sp[6 * TT_STRIDE], sp[7 * TT_STRIDE]);
        *(v4u*)(WT + (size_t)(n0 + n) * K + k0 + 8 * kg) = o; }
    __syncthreads();
}
__device__ __forceinline__ void cvt_stream(const float* src, bf16* dst, size_t n8, size_t gt, size_t GT) {
    for (size_t i = gt; i < n8; i += GT) {
        const f32x4 a = __builtin_nontemporal_load((const f32x4*)(src + i * 8)), b = __builtin_nontemporal_load((const f32x4*)(src + i * 8 + 4));
        v4u o; o.x = pk2(a.x, a.y); o.y = pk2(a.z, a.w); o.z = pk2(b.x, b.y); o.w = pk2(b.z, b.w);
        *(v4u*)(dst + i * 8) = o;
    }
}
template <int BIAS>
__device__ __forceinline__ void quant_rows(const float* src, unsigned char* dst, float* scl, int rbeg, int rend, int gw, int NGW, int lane) {
    constexpr int RB = 4;
    for (int r0 = rbeg + gw * RB; r0 < rend; r0 += NGW * RB) {
        f32x4 v[RB][4];
#pragma unroll
        for (int i = 0; i < RB; ++i)
#pragma unroll
            for (int j = 0; j < 4; ++j) v[i][j] = __builtin_nontemporal_load((const f32x4*)(src + (size_t)(r0 + i) * DM + 256 * j + 4 * lane));
#pragma unroll
        for (int i = 0; i < RB; ++i) {
            float m = 0.f;
#pragma unroll
            for (int j = 0; j < 4; ++j) m = fmaxf(m, fmaxf(fmaxf(fabsf(v[i][j].x), fabsf(v[i][j].y)), fmaxf(fabsf(v[i][j].z), fabsf(v[i][j].w))));
            m = wave_max(m);
            const float sc = m > 0.f ? m * (1.f / 127.f) : 1.f, inv = 1.f / sc;
#pragma unroll
            for (int j = 0; j < 4; ++j) {
                const int q0 = (int)rintf(v[i][j].x * inv) + BIAS, q1 = (int)rintf(v[i][j].y * inv) + BIAS, q2 = (int)rintf(v[i][j].z * inv) + BIAS, q3 = (int)rintf(v[i][j].w * inv) + BIAS;
                *(unsigned*)(dst + (size_t)((r0 + i) >> 14) * ((size_t)NEXP * DM) + (size_t)(2 * j + (lane >> 5)) * ((size_t)NEXP * 128) + (size_t)((r0 + i) & (NEXP - 1)) * 128 + ((4 * lane) & 127)) = (unsigned)(q0 & 255) | ((unsigned)(q1 & 255) << 8) | ((unsigned)(q2 & 255) << 16) | ((unsigned)(q3 & 255) << 24); }
            if (lane == 0) scl[2 * (r0 + i)] = sc;
        }
    }
}
__device__ __forceinline__ void norm_rows_phase(const float* X, const float* gvec, const float* modl, int sh_off, int sc_off, bf16* H, int gw, int NGW, int lane) {
    constexpr int RW = 8, RB = 4;
    for (int m0 = gw * RW; m0 < T; m0 += NGW * RW) {
        f32x4 v[RB][4];
#pragma unroll
        for (int i = 0; i < RB; ++i)
#pragma unroll
            for (int j = 0; j < 4; ++j) v[i][j] = __builtin_nontemporal_load((const f32x4*)(X + (size_t)(m0 + i) * DM + 256 * j + 4 * lane));
        const float* mb = modl + (size_t)(m0 >> 11) * NMOD;
        f32x4 gg[4], sh[4];
#pragma unroll
        for (int j = 0; j < 4; ++j) { const int k = 256 * j + 4 * lane; gg[j] = *(const f32x4*)(gvec + k) * (1.f + *(const f32x4*)(mb + sc_off + k)); sh[j] = *(const f32x4*)(mb + sh_off + k); }
#pragma unroll
        for (int r = 0; r < RW; ++r) {
            const int i = r & (RB - 1);
            float s = 0.f;
#pragma unroll
            for (int j = 0; j < 4; ++j) s += (v[i][j].x * v[i][j].x + v[i][j].y * v[i][j].y) + (v[i][j].z * v[i][j].z + v[i][j].w * v[i][j].w);
            const float rstd = rsqrtf(wave_sum(s) * (1.f / DM) + RMS_EPS);
#pragma unroll
            for (int j = 0; j < 4; ++j) { const f32x4 o = v[i][j] * rstd * gg[j] + sh[j]; v2u w; w.x = pk2(o.x, o.y); w.y = pk2(o.z, o.w);
                *(v2u*)(H + (size_t)(m0 + r) * DM + 256 * j + 4 * lane) = w; }
            if (r + RB < RW) {
#pragma unroll
                for (int j = 0; j < 4; ++j) v[i][j] = __builtin_nontemporal_load((const f32x4*)(X + (size_t)(m0 + r + RB) * DM + 256 * j + 4 * lane));
            }
            __builtin_amdgcn_sched_barrier(0);
        }
    }
}

constexpr int PL_STRIDE = 1040;
constexpr int KL_STRIDE = 144, KL_OFF = 0;
constexpr int VT_STRIDE = 392, VT_OFF = 55296;
constexpr int SSP_OFF = 106496, SSA_OFF = 108544;
__device__ __forceinline__ void unpack8(const v4u w, float (&f)[8]) {
    f[0] = bflo(w.x); f[1] = bfhi(w.x); f[2] = bflo(w.y); f[3] = bfhi(w.y); f[4] = bflo(w.z); f[5] = bfhi(w.z); f[6] = bflo(w.w); f[7] = bfhi(w.w); }
__device__ __forceinline__ v4u pack8(const float (&f)[8]) { v4u o; o.x = pk2(f[0], f[1]); o.y = pk2(f[2], f[3]); o.z = pk2(f[4], f[5]); o.w = pk2(f[6], f[7]); return o; }
template <int WIN>
__device__ __forceinline__ void pool_rows(const bf16* base, int pos0, LAS unsigned char* dst) {
    v4u rw[WIN + 7];
#pragma unroll
    for (int i = 0; i < WIN + 7; ++i) { const int rel = i - (WIN - 1); const bool ok = pos0 + rel >= 0; rw[i] = *(const v4u*)(base + (ptrdiff_t)(ok ? rel : 0) * INW); if (!ok) rw[i] = (v4u){0u, 0u, 0u, 0u}; }
    float sum[8], f[8];
#pragma unroll
    for (int k = 0; k < 8; ++k) sum[k] = 0.f;
#pragma unroll
    for (int i = 0; i < WIN - 1; ++i) { unpack8(rw[i], f);
#pragma unroll
        for (int k = 0; k < 8; ++k) sum[k] += f[k]; }
#pragma unroll
    for (int r = 0; r < 8; ++r) {
        float cur[8]; unpack8(rw[r + WIN - 1], cur);
#pragma unroll
        for (int k = 0; k < 8; ++k) sum[k] += cur[k];
        const int pos = pos0 + r; const float inv = 1.f / (float)((pos + 1) < WIN ? (pos + 1) : WIN);
#pragma unroll
        for (int k = 0; k < 8; ++k) f[k] = sum[k] * inv - cur[k];
        *(LAS v4u*)(dst + r * PL_STRIDE) = pack8(f);
        unpack8(rw[r], f);
#pragma unroll
        for (int k = 0; k < 8; ++k) sum[k] -= f[k];
    }
}
__device__ __forceinline__ void phase_mix(LAS unsigned char* lds, const bf16* PROJ, const bf16* PWT, const float* pool_scale, const float* qg, const float* kg,
                                          const float* sinks, const float* mixg, bf16* Y, int tid, int vcu, int G) {
    const int lane = tid & 63, wave = __builtin_amdgcn_readfirstlane(tid >> 6), l31 = lane & 31, hi = lane >> 5;
    LAS float* SSP = (LAS float*)(lds + SSP_OFF); LAS float* SSA = (LAS float*)(lds + SSA_OFF);
    for (int u = vcu; u < 256; u += G) {
        const int b = u >> 5, t0 = (u & 31) * 64; const size_t row0 = (size_t)b * SEQ + t0;
        {
            if (wave < 4) __builtin_amdgcn_s_setprio(1);
            const int g = (0x1023 >> (4 * (wave >> 1))) & 3, t128 = (wave & 1) * 64 + lane, ch = t128 & 15, rseg = t128 >> 4, col = g * 128 + ch * 8;
            const int r0 = rseg * 8, pos0 = t0 + r0;
            const bf16* base = PROJ + ((size_t)b * SEQ + pos0) * INW + col;
            switch (g) {
                case 0: pool_rows<2>(base, pos0, lds + r0 * PL_STRIDE + col * 2); break;
                case 1: pool_rows<4>(base, pos0, lds + r0 * PL_STRIDE + col * 2); break;
                case 2: pool_rows<8>(base, pos0, lds + r0 * PL_STRIDE + col * 2); break;
                default: pool_rows<16>(base, pos0, lds + r0 * PL_STRIDE + col * 2); break;
            }
            __builtin_amdgcn_s_setprio(0);
        }
        __syncthreads();
        bf16x8 afw[8][2];
        {
            const bf16* Wt = PWT + ((size_t)(wave >> 1) * 128 + (wave & 1) * 64) * 128;
#pragma unroll
            for (int s = 0; s < 8; ++s)
#pragma unroll
                for (int dt = 0; dt < 2; ++dt) afw[s][dt] = *(const bf16x8*)(Wt + (size_t)(dt * 32 + l31) * 128 + s * 16 + hi * 8);
        }
        __builtin_amdgcn_sched_barrier(0);
        f32x16 pacc[2][2];
        {
            const int g = wave >> 1, dh = wave & 1;
            const float* ps = pool_scale + g * 128 + dh * 64 + 4 * hi;
            f32x4 psc[2][4];
#pragma unroll
            for (int dt = 0; dt < 2; ++dt)
#pragma unroll
                for (int i = 0; i < 4; ++i) psc[dt][i] = *(const f32x4*)(ps + dt * 32 + 8 * i);
#pragma unroll
            for (int a = 0; a < 2; ++a)
#pragma unroll
                for (int c = 0; c < 2; ++c) pacc[a][c] = zero16();
#pragma unroll
            for (int s = 0; s < 8; ++s) {
                bf16x8 bfr[2];
#pragma unroll
                for (int tt = 0; tt < 2; ++tt) bfr[tt] = *(const LAS bf16x8*)(lds + (tt * 32 + l31) * PL_STRIDE + (g * 128 + s * 16 + hi * 8) * 2);
#pragma unroll
                for (int tt = 0; tt < 2; ++tt)
#pragma unroll
                    for (int dt = 0; dt < 2; ++dt) pacc[tt][dt] = mfma32(afw[s][dt], bfr[tt], pacc[tt][dt]);
            }
#pragma unroll
            for (int tt = 0; tt < 2; ++tt) {
                float ss = 0.f;
#pragma unroll
                for (int dt = 0; dt < 2; ++dt)
#pragma unroll
                    for (int i = 0; i < 4; ++i) { const f32x4 sc = psc[dt][i];
#pragma unroll
                        for (int e = 0; e < 4; ++e) { const float v = pacc[tt][dt][4 * i + e] * sc[e]; pacc[tt][dt][4 * i + e] = v; ss += v * v; } }
                ss = sum32(ss);
                if (hi == 0) SSP[(tt * 32 + l31) * 8 + wave] = ss;
            }
        }
        __syncthreads();
        {
            const int cb = (wave >> 1) * 128 + (wave & 1) * 64 + 4 * hi;
#pragma unroll
            for (int tt = 0; tt < 2; ++tt) {
                const int tok = tt * 32 + l31;
                const f32x4 s0 = *(const LAS f32x4*)(SSP + tok * 8), s1 = *(const LAS f32x4*)(SSP + tok * 8 + 4);
                const float rp = rsqrtf(((s0.x + s0.y) + (s0.z + s0.w) + (s1.x + s1.y) + (s1.z + s1.w)) * (1.f / 512.f) + RMS_EPS);
#pragma unroll
                for (int dt = 0; dt < 2; ++dt)
#pragma unroll
                    for (int i = 0; i < 4; ++i) { const int c = cb + dt * 32 + 8 * i; const f32x4 mg = *(const f32x4*)(mixg + c);
                        v2u w; w.x = pk2(pacc[tt][dt][4 * i] * rp * mg.x, pacc[tt][dt][4 * i + 1] * rp * mg.y); w.y = pk2(pacc[tt][dt][4 * i + 2] * rp * mg.z, pacc[tt][dt][4 * i + 3] * rp * mg.w);
                        *(LAS v2u*)(lds + tok * PL_STRIDE + c * 2) = w; }
            }
            __syncthreads();
#pragma unroll
            for (int i = 0; i < 8; ++i) { const int ck = tid + 512 * i, r = ck >> 6, pc = ck & 63; *(v4u*)(Y + (row0 + r) * DM + pc * 8) = *(const LAS v4u*)(lds + r * PL_STRIDE + pc * 16); }
            asm volatile("s_waitcnt lgkmcnt(0)" ::: "memory"); __builtin_amdgcn_s_barrier(); asm volatile("" ::: "memory");
        }
        const int hh = wave, kvh = hh >> 2;
        v4u qraw[2][4];
        int l31q = l31; asm volatile("" : "+v"(l31q));
#pragma unroll
        for (int qt = 0; qt < 2; ++qt) {
            const bf16* qp = PROJ + (row0 + qt * 32 + l31q) * INW + 512 + hh * 64 + hi * 8;
#pragma unroll
            for (int s = 0; s < 4; ++s) qraw[qt][s] = *(const v4u*)(qp + s * 16);
        }
        __builtin_amdgcn_sched_barrier(0);
        {
            const int part = tid & 7;
            const f32x4 g0 = *(const f32x4*)(kg + part * 8), g1 = *(const f32x4*)(kg + part * 8 + 4);
#pragma unroll 1
            for (int hb = 0; hb < 6; hb += 3) {
            v4u wk[3], wv[3];
#pragma unroll
            for (int i = 0; i < 3; ++i) {
                const int c = tid + 512 * (hb + i), kv = c / 1536, rem = c - kv * 1536, key = rem >> 3, kpos = t0 - 128 + key;
                const bf16* src = PROJ + ((size_t)b * SEQ + (kpos >= 0 ? kpos : 0)) * INW + 1024 + kv * 64 + part * 8;
                wk[i] = *(const v4u*)src; wv[i] = *(const v4u*)(src + 128);
            }
            __builtin_amdgcn_sched_barrier(0);
#pragma unroll
            for (int i = 0; i < 3; ++i) {
                const int c = tid + 512 * (hb + i), kv = c / 1536, rem = c - kv * 1536, key = rem >> 3, kpos = t0 - 128 + key;
                if (kpos < 0) { wk[i] = (v4u){0u, 0u, 0u, 0u}; wv[i] = (v4u){0u, 0u, 0u, 0u}; }
                float f[8]; unpack8(wk[i], f);
                float ss = 0.f;
#pragma unroll
                for (int k = 0; k < 8; ++k) ss += f[k] * f[k];
                ss += dpp_f<DPP_XOR1>(ss); ss += dpp_f<DPP_XOR2>(ss); ss += dpp_f<DPP_HMIRROR>(ss);
                const float rstd = rsqrtf(ss * (1.f / 64.f) + RMS_EPS);
                f[0] *= rstd * g0.x; f[1] *= rstd * g0.y; f[2] *= rstd * g0.z; f[3] *= rstd * g0.w; f[4] *= rstd * g1.x; f[5] *= rstd * g1.y; f[6] *= rstd * g1.z; f[7] *= rstd * g1.w;
                *(LAS v4u*)(lds + KL_OFF + (kv * 192 + key) * KL_STRIDE + part * 16) = pack8(f);
                LAS unsigned short* vt = (LAS unsigned short*)(lds + VT_OFF + (kv * 64 + part * 8) * VT_STRIDE + key * 2);
                vt[0 * (VT_STRIDE / 2)] = (unsigned short)(wv[i].x & 0xffffu); vt[1 * (VT_STRIDE / 2)] = (unsigned short)(wv[i].x >> 16);
                vt[2 * (VT_STRIDE / 2)] = (unsigned short)(wv[i].y & 0xffffu); vt[3 * (VT_STRIDE / 2)] = (unsigned short)(wv[i].y >> 16);
                vt[4 * (VT_STRIDE / 2)] = (unsigned short)(wv[i].z & 0xffffu); vt[5 * (VT_STRIDE / 2)] = (unsigned short)(wv[i].z >> 16);
                vt[6 * (VT_STRIDE / 2)] = (unsigned short)(wv[i].w & 0xffffu); vt[7 * (VT_STRIDE / 2)] = (unsigned short)(wv[i].w >> 16);
                __builtin_amdgcn_sched_barrier(0);
            }
            }
        }
        bf16x8 qf[2][4];
#pragma unroll
        for (int qt = 0; qt < 2; ++qt) {
            float f[4][8]; float ss = 0.f;
#pragma unroll
            for (int s = 0; s < 4; ++s) { unpack8(qraw[qt][s], f[s]);
#pragma unroll
                for (int k = 0; k < 8; ++k) ss += f[s][k] * f[s][k]; }
            ss = sum32(ss);
            const float rstd = rsqrtf(ss * (1.f / 64.f) + RMS_EPS) * (0.125f * LOG2E);
#pragma unroll
            for (int s = 0; s < 4; ++s) { const f32x4 g0 = *(const f32x4*)(qg + s * 16 + hi * 8), g1 = *(const f32x4*)(qg + s * 16 + hi * 8 + 4);
                f[s][0] *= rstd * g0.x; f[s][1] *= rstd * g0.y; f[s][2] *= rstd * g0.z; f[s][3] *= rstd * g0.w; f[s][4] *= rstd * g1.x; f[s][5] *= rstd * g1.y; f[s][6] *= rstd * g1.z; f[s][7] *= rstd * g1.w;
                qf[qt][s] = __builtin_bit_cast(bf16x8, pack8(f[s])); }
        }
        __syncthreads();
        f32x16 o[2][2];
#pragma unroll
        for (int a = 0; a < 2; ++a)
#pragma unroll
            for (int c = 0; c < 2; ++c) o[a][c] = zero16();
        float lsum[2] = {0.f, 0.f};
        const float slope = exp2f(-(float)(hh + 1)) * LOG2E;
        const int e_l = l31 - 4 * hi, kmin = t0 < 128 ? 128 - t0 : 0;
        const float se = slope * (float)e_l;
#define ATT_TILE(kti, MODE) do { const int kt = qt + (kti); if (kt * 32 >= kmin) { \
                f32x16 sc = zero16(); \
_Pragma("unroll") \
                for (int s = 0; s < 4; ++s) { const bf16x8 kf = *(const LAS bf16x8*)(lds + KL_OFF + (kvh * 192 + kt * 32 + l31) * KL_STRIDE + (s * 16 + hi * 8) * 2); sc = mfma32(kf, qf[qt][s], sc); } \
                const float nb = -slope * (float)(128 - 32 * kti) - se; \
                float p[16]; float ls = 0.f; \
_Pragma("unroll") \
                for (int r = 0; r < 16; ++r) { const int cr = (r & 3) + 8 * (r >> 2); \
                    float arg = __builtin_fmaf(slope, (float)cr, sc[r] + nb); \
                    if (MODE == 0) arg = (cr > e_l) ? arg : -200.f; \
                    if (MODE == 2) arg = (cr <= e_l) ? arg : -200.f; \
                    p[r] = __builtin_amdgcn_exp2f(arg); ls += p[r]; } \
                lsum[qt] += ls; \
                bf16x8 pf[2]; \
_Pragma("unroll") \
                for (int s2 = 0; s2 < 2; ++s2) { v4u w; w.x = pk2(p[8 * s2], p[8 * s2 + 1]); w.y = pk2(p[8 * s2 + 2], p[8 * s2 + 3]); w.z = pk2(p[8 * s2 + 4], p[8 * s2 + 5]); w.w = pk2(p[8 * s2 + 6], p[8 * s2 + 7]); pf[s2] = __builtin_bit_cast(bf16x8, w); } \
_Pragma("unroll") \
                for (int dt = 0; dt < 2; ++dt) \
_Pragma("unroll") \
                    for (int s2 = 0; s2 < 2; ++s2) { const LAS unsigned char* ap = lds + VT_OFF + (kvh * 64 + dt * 32 + l31) * VT_STRIDE + (kt * 32 + s2 * 16 + hi * 4) * 2; \
                        const v2u a0 = *(const LAS v2u*)ap, a1 = *(const LAS v2u*)(ap + 16); v4u av; av.x = a0.x; av.y = a0.y; av.z = a1.x; av.w = a1.y; \
                        o[qt][dt] = mfma32(__builtin_bit_cast(bf16x8, av), pf[s2], o[qt][dt]); } } } while (0)
#pragma unroll
        for (int qt = 0; qt < 2; ++qt) {
            ATT_TILE(0, 0);
#pragma unroll 1
            for (int kti = 1; kti < 4; ++kti) ATT_TILE(kti, 1);
            ATT_TILE(4, 2);
        }
#undef ATT_TILE
        const float sink = exp2f(sinks[hh] * LOG2E);
#pragma unroll
        for (int qt = 0; qt < 2; ++qt) {
            const float lt = sum32(lsum[qt]); const float inv = 1.f / (lt + sink); float ss = 0.f;
#pragma unroll
            for (int dt = 0; dt < 2; ++dt)
#pragma unroll
                for (int r = 0; r < 16; ++r) { const float v = o[qt][dt][r] * inv; o[qt][dt][r] = v; ss += v * v; }
            ss = sum32(ss);
            if (hi == 0) SSA[(qt * 32 + l31) * 8 + hh] = ss;
        }
        __syncthreads();
        {
            const int cb = hh * 64 + 4 * hi;
#pragma unroll
            for (int tt = 0; tt < 2; ++tt) {
                const int tok = tt * 32 + l31;
                const f32x4 s0 = *(const LAS f32x4*)(SSA + tok * 8), s1 = *(const LAS f32x4*)(SSA + tok * 8 + 4);
                const float ra = rsqrtf(((s0.x + s0.y) + (s0.z + s0.w) + (s1.x + s1.y) + (s1.z + s1.w)) * (1.f / 512.f) + RMS_EPS);
#pragma unroll
                for (int dt = 0; dt < 2; ++dt)
#pragma unroll
                    for (int i = 0; i < 4; ++i) { const int c = cb + dt * 32 + 8 * i; const f32x4 mg = *(const f32x4*)(mixg + 512 + c);
                        v2u w; w.x = pk2(o[tt][dt][4 * i] * ra * mg.x, o[tt][dt][4 * i + 1] * ra * mg.y); w.y = pk2(o[tt][dt][4 * i + 2] * ra * mg.z, o[tt][dt][4 * i + 3] * ra * mg.w);
                        *(LAS v2u*)(lds + tok * PL_STRIDE + c * 2) = w; }
            }
            __syncthreads();
#pragma unroll
            for (int i = 0; i < 8; ++i) { const int ck = tid + 512 * i, r = ck >> 6, pc = ck & 63; *(v4u*)(Y + (row0 + r) * DM + 512 + pc * 8) = *(const LAS v4u*)(lds + r * PL_STRIDE + pc * 16); }
        }
        if (u + G < 256) __syncthreads();
    }
}

#ifndef VREP
#define VREP 1
#endif
#ifndef UREP
#define UREP 1
#endif
#ifndef TOPK_REP
#define TOPK_REP 1
#endif
#ifndef GATHER_PARTS
#define GATHER_PARTS 3
#endif
#ifndef PEER_PARTS
#define PEER_PARTS 3
#endif
constexpr int SK_STRIDE = 272, SK_OFF = 0;
constexpr int EI_OFF = 98304, EG_OFF = 131072;
constexpr int TKS_OFF = 69632;
constexpr int SHS_OFF = 147456;
constexpr int W_OFF = 0, H8_OFF = 32768;
#define CE_DESC(a, b) do { const float _h = fmaxf(a, b), _l = fminf(a, b); a = _h; b = _l; } while (0)
__device__ __forceinline__ void sort16(float (&L)[16]) { CE_DESC(L[0], L[1]); CE_DESC(L[2], L[3]); CE_DESC(L[4], L[5]); CE_DESC(L[6], L[7]); CE_DESC(L[8], L[9]); CE_DESC(L[10], L[11]); CE_DESC(L[12], L[13]); CE_DESC(L[14], L[15]); CE_DESC(L[0], L[2]); CE_DESC(L[1], L[3]); CE_DESC(L[4], L[6]); CE_DESC(L[5], L[7]); CE_DESC(L[8], L[10]); CE_DESC(L[9], L[11]); CE_DESC(L[12], L[14]); CE_DESC(L[13], L[15]); CE_DESC(L[1], L[2]); CE_DESC(L[5], L[6]); CE_DESC(L[9], L[10]); CE_DESC(L[13], L[14]); CE_DESC(L[0], L[4]); CE_DESC(L[1], L[5]); CE_DESC(L[2], L[6]); CE_DESC(L[3], L[7]); CE_DESC(L[8], L[12]); CE_DESC(L[9], L[13]); CE_DESC(L[10], L[14]); CE_DESC(L[11], L[15]); CE_DESC(L[2], L[4]); CE_DESC(L[3], L[5]); CE_DESC(L[10], L[12]); CE_DESC(L[11], L[13]); CE_DESC(L[1], L[2]); CE_DESC(L[3], L[4]); CE_DESC(L[5], L[6]); CE_DESC(L[9], L[10]); CE_DESC(L[11], L[12]); CE_DESC(L[13], L[14]); CE_DESC(L[0], L[8]); CE_DESC(L[1], L[9]); CE_DESC(L[2], L[10]); CE_DESC(L[3], L[11]); CE_DESC(L[4], L[12]); CE_DESC(L[5], L[13]); CE_DESC(L[6], L[14]); CE_DESC(L[7], L[15]); CE_DESC(L[4], L[8]); CE_DESC(L[5], L[9]); CE_DESC(L[6], L[10]); CE_DESC(L[7], L[11]); CE_DESC(L[2], L[4]); CE_DESC(L[3], L[5]); CE_DESC(L[6], L[8]); CE_DESC(L[7], L[9]); CE_DESC(L[10], L[12]); CE_DESC(L[11], L[13]); CE_DESC(L[1], L[2]); CE_DESC(L[3], L[4]); CE_DESC(L[5], L[6]); CE_DESC(L[7], L[8]); CE_DESC(L[9], L[10]); CE_DESC(L[11], L[12]); CE_DESC(L[13], L[14]); }
__device__ __forceinline__ void bmerge16(float (&M)[16]) {
#pragma unroll
    for (int d = 8; d >= 1; d >>= 1)
#pragma unroll
        for (int i = 0; i < 16; ++i) if ((i & d) == 0) CE_DESC(M[i], M[i + d]);
}
__device__ __forceinline__ void merge16(float (&Tt)[16], const float (&C)[16]) {
#pragma unroll
    for (int i = 0; i < 16; ++i) Tt[i] = fmaxf(Tt[i], C[15 - i]);
    bmerge16(Tt);
}
__device__ __forceinline__ float erf_as(float x) {
    const float ax = fabsf(x), t = __builtin_amdgcn_rcpf(1.f + 0.3275911f * ax);
    const float poly = ((((1.061405429f * t - 1.453152027f) * t + 1.421413741f) * t - 0.284496736f) * t + 0.254829592f) * t;
    const float y = 1.f - poly * __expf(-ax * ax);
    return copysignf(y, x);
}
__device__ __forceinline__ float clrbits(float v, unsigned m) { return __uint_as_float(__float_as_uint(v) & ~m); }
__device__ __forceinline__ void phase_peer(LAS unsigned char* lds, const bf16* QP, const bf16* SUBK, const unsigned char* U8, const unsigned char* V8, const float* SU, const float* SV, float* X, const float* modl, const float* n2g,
                                           const float* n1g_next, const float* mod_next, bf16* H, int tid, int bid, int G, float xscale) {
    const int lane = tid & 63, wave = __builtin_amdgcn_readfirstlane(tid >> 6), l31 = lane & 31, hi = lane >> 5;
    LAS unsigned* EI = (LAS unsigned*)(lds + EI_OFF); LAS _Float16* EG = (LAS _Float16*)(lds + EG_OFF);
    for (int u = bid; u < 256; u += G) {
        const size_t row0 = (size_t)u * 64; const int b = u >> 5;
        LAS unsigned char* IJT = lds + TKS_OFF;
        LAS unsigned char* NB = lds + TKS_OFF + 64 + (wave * 64 + lane) * 32;
        if (tid < 50) { const int c = tid;
            const int ii = (c >= 16) + (c >= 24) + (c >= 29) + (c >= 33) + (c >= 36) + (c >= 38) + (c >= 40) + (c >= 42) + (c > 42 ? c - 42 : 0);
            const int st = ii == 0 ? 0 : ii == 1 ? 16 : ii == 2 ? 24 : ii == 3 ? 29 : ii == 4 ? 33 : ii == 5 ? 36 : ii == 6 ? 38 : ii == 7 ? 40 : 34 + ii;
            IJT[c] = (unsigned char)((ii << 4) | (c - st)); }
        {
            v4u sk[8];
            int tid_s = tid; asm volatile("" : "+v"(tid_s));
            const bf16* skp = SUBK + (size_t)tid_s * 8;
#pragma unroll
            for (int k = 0; k < 8; ++k) sk[k] = *(const v4u*)(skp + (size_t)k * 4096);
#pragma unroll
            for (int k = 0; k < 8; ++k) { const int i = tid_s + 512 * k, row = i >> 4, ch = i & 15; *(LAS v4u*)(lds + SK_OFF + row * SK_STRIDE + ch * 16) = sk[k]; }
        }
        __syncthreads();
#pragma unroll 1
        for (int tt2 = 0; tt2 < ((PEER_PARTS & 1) ? 2 * TOPK_REP : 0); ++tt2) {
            const int tt = tt2 & 1;
            float L[2][16];
#pragma unroll
            for (int p = 0; p < 2; ++p) {
                bf16x8 qf[8];
                const int rg = (int)row0 + tt * 32 + l31, rr = rg & 255;
                const bf16* qp = QP + ((size_t)(rg >> 8) * 8 + wave) * 65536 + ((((rr >> 7) * 4 + ((rr >> 4) & 3)) * 2 + p) * 4096) + (((rr >> 6) & 1) * 4 * 64 + (rr & 15)) * 8;
#pragma unroll
                for (int s = 0; s < 8; ++s) qf[s] = *(const bf16x8*)(qp + ((s >> 1) * 64 + ((2 * s + hi) & 3) * 16) * 8);
                float Tt[16];
#pragma unroll
                for (int np = 0; np < 2; ++np) {
                    f32x16 acc[2]; acc[0] = zero16(); acc[1] = zero16();
#pragma unroll
                    for (int s = 0; s < 8; ++s)
#pragma unroll
                        for (int n2 = 0; n2 < 2; ++n2) { const bf16x8 kf = *(const LAS bf16x8*)(lds + SK_OFF + (p * 128 + (np * 2 + n2) * 32 + l31) * SK_STRIDE + (s * 16 + hi * 8) * 2); acc[n2] = mfma32(kf, qf[s], acc[n2]); }
#pragma unroll
                    for (int n2 = 0; n2 < 2; ++n2) {
                        float C[16];
#pragma unroll
                        for (int r = 0; r < 16; ++r) C[r] = __uint_as_float((__float_as_uint(acc[n2][r]) & ~127u) | (unsigned)((np * 2 + n2) * 32 + (r & 3) + 8 * (r >> 2)));
                        sort16(C);
                        if (np == 0 && n2 == 0) {
#pragma unroll
                            for (int i = 0; i < 16; ++i) Tt[i] = C[i];
                        } else merge16(Tt, C);
                    }
                }
#pragma unroll
                for (int i = 0; i < 16; ++i) Tt[i] = __uint_as_float(__float_as_uint(Tt[i]) | ((unsigned)hi << 2));
                float M[16];
#pragma unroll
                for (int i = 0; i < 16; ++i) M[i] = xchg32(Tt[i], hi);
                merge16(Tt, M);
#pragma unroll
                for (int i = 0; i < 16; ++i) L[p][i] = Tt[i];
            }
            float A1[16], B2[16];
#pragma unroll
            for (int i = 0; i < 16; ++i) { A1[i] = clrbits(L[0][i], 127u); B2[i] = clrbits(L[1][i], 127u); }
#define CAND(i, j, c) __uint_as_float((__float_as_uint(A1[i] + B2[j]) & ~127u) | (unsigned)(c))
            float Cc[16];
#pragma unroll
            for (int j = 0; j < 16; ++j) Cc[j] = CAND(0, j, j);
#pragma unroll
            for (int j = 0; j < 8; ++j) Cc[15 - j] = fmaxf(Cc[15 - j], CAND(1, j, 16 + j));
            bmerge16(Cc);
            {
                float Bc[16] = {CAND(2, 0, 24), CAND(2, 1, 25), CAND(2, 2, 26), CAND(2, 3, 27), CAND(2, 4, 28), CAND(3, 0, 29), CAND(3, 1, 30), CAND(3, 2, 31), CAND(3, 3, 32),
                                CAND(4, 0, 33), CAND(4, 1, 34), CAND(4, 2, 35), CAND(5, 0, 36), CAND(5, 1, 37), -INFINITY, -INFINITY};
                sort16(Bc); merge16(Cc, Bc);
                float Dc[16] = {CAND(6, 0, 38), CAND(6, 1, 39), CAND(7, 0, 40), CAND(7, 1, 41), CAND(8, 0, 42), CAND(9, 0, 43), CAND(10, 0, 44), CAND(11, 0, 45), CAND(12, 0, 46),
                                CAND(13, 0, 47), CAND(14, 0, 48), CAND(15, 0, 49), -INFINITY, -INFINITY, -INFINITY, -INFINITY};
                sort16(Dc); merge16(Cc, Dc);
            }
#undef CAND
            const float mx = clrbits(Cc[0], 127u); float ex[16]; float se = 0.f;
#pragma unroll
            for (int k = 0; k < 16; ++k) { ex[k] = __expf(clrbits(Cc[k], 127u) - mx); se += ex[k]; }
            const float inv = 1.f / se;
            {
                v4u n1p, n2p;
#pragma unroll
                for (int q = 0; q < 4; ++q) {
                    n1p[q] = (__float_as_uint(L[0][4 * q]) & 127u) | ((__float_as_uint(L[0][4 * q + 1]) & 127u) << 8) | ((__float_as_uint(L[0][4 * q + 2]) & 127u) << 16) | ((__float_as_uint(L[0][4 * q + 3]) & 127u) << 24);
                    n2p[q] = (__float_as_uint(L[1][4 * q]) & 127u) | ((__float_as_uint(L[1][4 * q + 1]) & 127u) << 8) | ((__float_as_uint(L[1][4 * q + 2]) & 127u) << 16) | ((__float_as_uint(L[1][4 * q + 3]) & 127u) << 24); }
                *(LAS v4u*)NB = n1p; *(LAS v4u*)(NB + 16) = n2p;
            }
#pragma unroll
            for (int k = 0; k < 16; ++k) {
                const unsigned ij = IJT[__float_as_uint(Cc[k]) & 127u];
                const unsigned n1 = NB[ij >> 4], n2 = NB[16 + (ij & 15u)];
                if (hi == 0) { EI[(tt * 32 + l31) * 128 + wave * 16 + k] = (n1 << 14) | (n2 << 7); EG[(tt * 32 + l31) * 128 + wave * 16 + k] = (_Float16)(ex[k] * inv); }
            }
        }
        f32x4 xa[4][4];
        int lane_h = lane; asm volatile("" : "+v"(lane_h));
        const float* xw = X + (row0 + wave) * DM + 4 * lane_h;
#pragma unroll
        for (int i = 0; i < 4; ++i)
#pragma unroll
            for (int q = 0; q < 4; ++q) xa[i][q] = *(const f32x4*)(xw + (size_t)(8 * i) * DM + 256 * q);
        __builtin_amdgcn_sched_barrier(0);
        asm volatile("s_waitcnt lgkmcnt(0)" ::: "memory"); __builtin_amdgcn_s_barrier(); asm volatile("" ::: "memory");
        const float* mb = modl + (size_t)b * NMOD;
        LAS float* Wl = (LAS float*)(lds + W_OFF); LAS unsigned char* H8 = lds + H8_OFF;
        const int j8 = lane & 7, g8 = lane >> 3;
        const int b0 = lane & 1, b1 = (lane >> 1) & 1, b2 = (lane >> 2) & 1, b3 = (lane >> 3) & 1, b4 = (lane >> 4) & 1;
        if (PEER_PARTS & 2) {
        LAS float* SHS = (LAS float*)(lds + SHS_OFF);
        {
            f32x4 gg[4], shv[4];
#pragma unroll
            for (int q = 0; q < 4; ++q) { const int k = 256 * q + 4 * lane; gg[q] = *(const f32x4*)(n2g + k) * (1.f + *(const f32x4*)(mb + 4096 + k)); shv[q] = *(const f32x4*)(mb + 3072 + k); }
            {
#pragma unroll
                for (int r8 = 0; r8 < 8; ++r8) {
                    const int i = r8 & 3;
                    const int tk = wave + 8 * r8; float ss = 0.f;
#pragma unroll
                    for (int q = 0; q < 4; ++q) ss += (xa[i][q].x * xa[i][q].x + xa[i][q].y * xa[i][q].y) + (xa[i][q].z * xa[i][q].z + xa[i][q].w * xa[i][q].w);
                    const float rstd = rsqrtf(wave_sum(ss) * (1.f / DM) + RMS_EPS);
                    f32x4 h2[4]; float hm = 0.f;
#pragma unroll
                    for (int q = 0; q < 4; ++q) { h2[q] = xa[i][q] * rstd * gg[q] + shv[q];
                        hm = fmaxf(hm, fmaxf(fmaxf(fabsf(h2[q].x), fabsf(h2[q].y)), fmaxf(fabsf(h2[q].z), fabsf(h2[q].w)))); }
                    hm = wave_max(hm);
                    const float sc1 = hm > 0.f ? hm * (1.f / 127.f) : 1.f, hinv = 1.f / sc1;
#pragma unroll
                    for (int q = 0; q < 4; ++q) { const int q0 = (int)rintf(h2[q].x * hinv), q1 = (int)rintf(h2[q].y * hinv), q2 = (int)rintf(h2[q].z * hinv), q3 = (int)rintf(h2[q].w * hinv);
                        *(LAS unsigned*)(H8 + tk * 1024 + 256 * q + 4 * lane) = (unsigned)(q0 & 255) | ((unsigned)(q1 & 255) << 8) | ((unsigned)(q2 & 255) << 16) | ((unsigned)(q3 & 255) << 24); }
                    if (lane == 0) SHS[tk] = sc1;
                    if (r8 < 4) {
#pragma unroll
                        for (int q = 0; q < 4; ++q) xa[i][q] = *(const f32x4*)(xw + (size_t)(8 * (r8 + 4)) * DM + 256 * q);
                    }
                    __builtin_amdgcn_sched_barrier(0);
                }
            }
        }
        v4u bufA[16], bufB[16];
        const unsigned joff = (unsigned)j8 * 16u;
#define PEER_ISSUE(buf, TAB, sl, ti) do { __builtin_amdgcn_sched_barrier(0); { const int tk_ = wave + 8 * (ti); \
            const GAS unsigned char* sb_ = (const GAS unsigned char*)(TAB) + (size_t)(sl) * ((size_t)NEXP * 128); asm volatile("" : "+s"(sb_)); \
            _Pragma("unroll") for (int q_ = 0; q_ < 4; ++q_) { const v4u e4_ = *(const LAS v4u*)(EI + tk_ * 128 + g8 * 16 + 4 * q_); \
                _Pragma("unroll") for (int r_ = 0; r_ < 4; ++r_) buf[4 * q_ + r_] = *(const GAS v4u*)(sb_ + (e4_[r_] | joff)); } } __builtin_amdgcn_sched_barrier(0); } while (0)
#define PEER_DOT(r_, hq_) __builtin_amdgcn_sdot4((int)(r_).w, (int)hq_.w, __builtin_amdgcn_sdot4((int)(r_).z, (int)hq_.z, __builtin_amdgcn_sdot4((int)(r_).y, (int)hq_.y, dot4_first((r_).x, hq_.x), false), false), false)
#define PEER_UCOMP(buf, sl, ti) do { const int tk_ = wave + 8 * (ti); const v4u hq_ = *(const LAS v4u*)(H8 + tk_ * 1024 + (sl) * 128 + j8 * 16); \
              \
            int q8_[8], q4_[4]; \
            _Pragma("unroll") for (int k_ = 0; k_ < 8; ++k_) { const int p0_ = PEER_DOT(buf[k_], hq_), p1_ = PEER_DOT(buf[k_ + 8], hq_); const int snd_ = b2 ? p0_ : p1_, kp_ = b2 ? p1_ : p0_; q8_[k_] = kp_ + dpp_i<DPP_HMIRROR>(snd_); } \
            _Pragma("unroll") for (int k_ = 0; k_ < 4; ++k_) { const int snd_ = b1 ? q8_[k_] : q8_[k_ + 4], kp_ = b1 ? q8_[k_ + 4] : q8_[k_]; q4_[k_] = kp_ + dpp_i<DPP_XOR2>(snd_); } \
            _Pragma("unroll") for (int k_ = 0; k_ < 2; ++k_) { const int snd_ = b0 ? q4_[k_] : q4_[k_ + 2], kp_ = b0 ? q4_[k_ + 2] : q4_[k_]; pa[ti][k_] += kp_ + dpp_i<DPP_XOR1>(snd_); } \
            asm volatile("" : "+v"(pa[ti][0]), "+v"(pa[ti][1])); } while (0)
        int pa[8][2];
#pragma unroll 1
        for (int urep = 0; urep < UREP; ++urep) {
#pragma unroll
        for (int ti = 0; ti < 8; ++ti) { pa[ti][0] = 0; pa[ti][1] = 0; }
        if (wave >= 4) __builtin_amdgcn_s_setprio(GPRIO);
        PEER_ISSUE(bufA, U8, 0, 0);
#pragma unroll 1
        for (int sl = 0; sl < ((GATHER_PARTS & 1) ? 8 : 0); ++sl) {
            if (STAG_U > 0 && wave >= 4) __builtin_amdgcn_s_sleep(STAG_U);
            PEER_ISSUE(bufB, U8, sl, 1); PEER_UCOMP(bufA, sl, 0);
            PEER_ISSUE(bufA, U8, sl, 2); PEER_UCOMP(bufB, sl, 1);
            PEER_ISSUE(bufB, U8, sl, 3); PEER_UCOMP(bufA, sl, 2);
            PEER_ISSUE(bufA, U8, sl, 4); PEER_UCOMP(bufB, sl, 3);
            PEER_ISSUE(bufB, U8, sl, 5); PEER_UCOMP(bufA, sl, 4);
            PEER_ISSUE(bufA, U8, sl, 6); PEER_UCOMP(bufB, sl, 5);
            PEER_ISSUE(bufB, U8, sl, 7); PEER_UCOMP(bufA, sl, 6);
            if (sl < 7) PEER_ISSUE(bufA, U8, sl + 1, 0);
            PEER_UCOMP(bufB, sl, 7);
            __builtin_amdgcn_s_barrier();
        }
        }
        LAS float* SWS = (LAS float*)(lds + SHS_OFF + 256);
        int lane_w = lane; asm volatile("" : "+v"(lane_w));
        LAS unsigned char* W8 = lds + W_OFF;
        float su_[8][2], sv_[8][2];
#pragma unroll
        for (int ti = 0; ti < 8; ++ti) {
            const int tk = wave + 8 * ti;
            const v2u ew = *(const LAS v2u*)(EI + tk * 128 + 2 * lane_w); const unsigned e0 = ew.x >> 7, e1 = ew.y >> 7;
            { const f32x2_t s0 = *(const f32x2_t*)(SU + 2 * e0), s1 = *(const f32x2_t*)(SU + 2 * e1); su_[ti][0] = s0.x; sv_[ti][0] = s0.y; su_[ti][1] = s1.x; sv_[ti][1] = s1.y; }
        }
#pragma unroll
        for (int ti = 0; ti < 8; ++ti) {
            const int tk = wave + 8 * ti;
            typedef _Float16 h2_t __attribute__((ext_vector_type(2)));
            const h2_t gg = *(const LAS h2_t*)(EG + tk * 128 + 2 * lane_w);
            const float shs_t = SHS[tk];
            const float a0 = (float)pa[ti][0] * (shs_t * su_[ti][0]), a1 = (float)pa[ti][1] * (shs_t * su_[ti][1]);
            const float w0 = 0.5f * a0 * (1.f + erf_as(a0 * 0.70710678118f)) * (float)gg.x * sv_[ti][0], w1 = 0.5f * a1 * (1.f + erf_as(a1 * 0.70710678118f)) * (float)gg.y * sv_[ti][1];
            const float wm = wave_max(fmaxf(fabsf(w0), fabsf(w1)));
            const float sw = wm > 0.f ? wm * (1.f / 127.f) : 1.f, winv = 1.f / sw;
            const int q0 = (int)rintf(w0 * winv), q1 = (int)rintf(w1 * winv);
            *(LAS unsigned short*)(W8 + tk * 128 + 2 * lane_w) = (unsigned short)((unsigned)(q0 & 255) | ((unsigned)(q1 & 255) << 8));
            if (lane_w == 0) SWS[tk] = sw;
            __builtin_amdgcn_sched_barrier(0);
        }
#define PEER_VCOMP(buf, xpre, g2pre, sl, ti) do { const int tk_ = wave + 8 * (ti); const v4u wq_ = *(const LAS v4u*)(W8 + tk_ * 128 + g8 * 16); int o_[16]; \
            _Pragma("unroll") for (int q_ = 0; q_ < 4; ++q_) _Pragma("unroll") for (int c_ = 0; c_ < 4; ++c_) { \
                const unsigned r0_ = buf[4 * q_][c_], r1_ = buf[4 * q_ + 1][c_], r2_ = buf[4 * q_ + 2][c_], r3_ = buf[4 * q_ + 3][c_]; \
                const unsigned t0_ = __builtin_amdgcn_perm(r1_, r0_, 0x05010400u), t1_ = __builtin_amdgcn_perm(r1_, r0_, 0x07030602u), t2_ = __builtin_amdgcn_perm(r3_, r2_, 0x05010400u), t3_ = __builtin_amdgcn_perm(r3_, r2_, 0x07030602u); \
                o_[4 * c_] = (q_ == 0) ? dot4_first(__builtin_amdgcn_perm(t2_, t0_, 0x05040100u), wq_[q_]) : __builtin_amdgcn_sdot4((int)__builtin_amdgcn_perm(t2_, t0_, 0x05040100u), (int)wq_[q_], o_[4 * c_], false); \
                o_[4 * c_ + 1] = (q_ == 0) ? dot4_first(__builtin_amdgcn_perm(t2_, t0_, 0x07060302u), wq_[q_]) : __builtin_amdgcn_sdot4((int)__builtin_amdgcn_perm(t2_, t0_, 0x07060302u), (int)wq_[q_], o_[4 * c_ + 1], false); \
                o_[4 * c_ + 2] = (q_ == 0) ? dot4_first(__builtin_amdgcn_perm(t3_, t1_, 0x05040100u), wq_[q_]) : __builtin_amdgcn_sdot4((int)__builtin_amdgcn_perm(t3_, t1_, 0x05040100u), (int)wq_[q_], o_[4 * c_ + 2], false); \
                o_[4 * c_ + 3] = (q_ == 0) ? dot4_first(__builtin_amdgcn_perm(t3_, t1_, 0x07060302u), wq_[q_]) : __builtin_amdgcn_sdot4((int)__builtin_amdgcn_perm(t3_, t1_, 0x07060302u), (int)wq_[q_], o_[4 * c_ + 3], false); } \
              \
            int r8_[8], r4_[4], r2_[2]; \
            _Pragma("unroll") for (int k_ = 0; k_ < 8; ++k_) { unsigned a_ = (unsigned)o_[k_], b_ = (unsigned)o_[k_ + 8]; swap32(a_, b_); r8_[k_] = (int)(a_ + b_); } \
            _Pragma("unroll") for (int k_ = 0; k_ < 4; ++k_) { unsigned a_ = (unsigned)r8_[k_], b_ = (unsigned)r8_[k_ + 4]; swap16(a_, b_); r4_[k_] = (int)(a_ + b_); } \
            _Pragma("unroll") for (int k_ = 0; k_ < 2; ++k_) { const int snd_ = b3 ? r4_[k_] : r4_[k_ + 2], kp_ = b3 ? r4_[k_ + 2] : r4_[k_]; r2_[k_] = kp_ + dpp_i<DPP_ROR8>(snd_); } \
              \
            GAS unsigned char* xb_ = (GAS unsigned char*)X + ((size_t)(row0 + tk_) * DM + (size_t)(sl) * 128) * 4; asm volatile("" : "+s"(xb_)); GAS f32x2_t* xp_ = (GAS f32x2_t*)(xb_ + lo4); const float c_ = SWS[tk_] * vscale; \
            f32x2_t xv_ = xpre; xv_.x += g2pre.x * (c_ * (float)r2_[0]); xv_.y += g2pre.y * (c_ * (float)r2_[1]); *xp_ = xv_; __hip_atomic_fetch_add(SSQL + (ti) * 64, vscale * (xv_.x * xv_.x + xv_.y * xv_.y), __ATOMIC_RELAXED, __HIP_MEMORY_SCOPE_WORKGROUP); } while (0)
#define PEER_XPRE(xd, gd, sl, ti) do { const GAS unsigned char* xq_ = (const GAS unsigned char*)X + ((size_t)(row0 + wave + 8 * (ti)) * DM + (size_t)(sl) * 128) * 4; asm volatile("" : "+s"(xq_)); xd = *(const GAS f32x2_t*)(xq_ + lo4); } while (0)
        LAS float* SSQL = (LAS float*)(lds + H8_OFF) + wave * 512 + lane;
#pragma unroll
        for (int ti = 0; ti < 8; ++ti) SSQL[ti * 64] = 0.f;
        f32x2_t xpA, xpB, g2A; const f32x2_t& g2B = g2A;
        const unsigned lo4 = (unsigned)(j8 * 16 + 2 * g8) * 4u;
#pragma unroll 1
        for (int vrep = 0; vrep < VREP; ++vrep) {
        const float vscale = (vrep == VREP - 1) ? xscale : 0.f;
        PEER_ISSUE(bufA, V8, 0, 0); PEER_XPRE(xpA, g2A, 0, 0);
#pragma unroll 1
        for (int sl = 0; sl < ((GATHER_PARTS & 2) ? 8 : 0); ++sl) {
            g2A = *(const f32x2_t*)(mb + 5120 + sl * 128 + j8 * 16 + 2 * g8);
            if (STAG_V > 0 && wave >= 4) __builtin_amdgcn_s_sleep(STAG_V);
            PEER_ISSUE(bufB, V8, sl, 1); PEER_XPRE(xpB, g2B, sl, 1); PEER_VCOMP(bufA, xpA, g2A, sl, 0);
            PEER_ISSUE(bufA, V8, sl, 2); PEER_XPRE(xpA, g2A, sl, 2); PEER_VCOMP(bufB, xpB, g2B, sl, 1);
            PEER_ISSUE(bufB, V8, sl, 3); PEER_XPRE(xpB, g2B, sl, 3); PEER_VCOMP(bufA, xpA, g2A, sl, 2);
            PEER_ISSUE(bufA, V8, sl, 4); PEER_XPRE(xpA, g2A, sl, 4); PEER_VCOMP(bufB, xpB, g2B, sl, 3);
            PEER_ISSUE(bufB, V8, sl, 5); PEER_XPRE(xpB, g2B, sl, 5); PEER_VCOMP(bufA, xpA, g2A, sl, 4);
            PEER_ISSUE(bufA, V8, sl, 6); PEER_XPRE(xpA, g2A, sl, 6); PEER_VCOMP(bufB, xpB, g2B, sl, 5);
            PEER_ISSUE(bufB, V8, sl, 7); PEER_XPRE(xpB, g2B, sl, 7); PEER_VCOMP(bufA, xpA, g2A, sl, 6);
            if (sl < 7) { PEER_ISSUE(bufA, V8, sl + 1, 0); PEER_XPRE(xpA, g2A, sl + 1, 0); }
            PEER_VCOMP(bufB, xpB, g2B, sl, 7);
            __builtin_amdgcn_s_barrier();
        }
        if (VREP > 1) { asm volatile("s_waitcnt vmcnt(0)" ::: "memory"); }
        }
        __builtin_amdgcn_s_setprio(0);
#undef PEER_ISSUE
#undef PEER_UCOMP
#undef PEER_VCOMP
#undef PEER_XPRE
        if (n1g_next) {
            asm volatile("s_waitcnt vmcnt(0)" ::: "memory"); __builtin_amdgcn_fence(__ATOMIC_ACQ_REL, "workgroup");
            const float* mn = mod_next + (size_t)b * NMOD;
            f32x4 gg[4], shv[4];
#pragma unroll
            for (int q = 0; q < 4; ++q) { const int k = 256 * q + 4 * lane; gg[q] = *(const f32x4*)(n1g_next + k) * (1.f + *(const f32x4*)(mn + 1024 + k)); shv[q] = *(const f32x4*)(mn + k); }
#pragma unroll
            for (int tq = 0; tq < 2; ++tq) {
                f32x4 xa[4][4];
#pragma unroll
                for (int i = 0; i < 4; ++i)
#pragma unroll
                    for (int q = 0; q < 4; ++q) xa[i][q] = *(const f32x4*)(X + (row0 + wave + 8 * (4 * tq + i)) * DM + 256 * q + 4 * lane);
#pragma unroll
                for (int i = 0; i < 4; ++i) {
                    const int tk = wave + 8 * (4 * tq + i); bf16* hr = H + (row0 + tk) * DM;
                    const float rs2 = rsqrtf(wave_sum(SSQL[(4 * tq + i) * 64]) * (1.f / DM) + RMS_EPS);
#pragma unroll
                    for (int q = 0; q < 4; ++q) { const f32x4 h = xa[i][q] * rs2 * gg[q] + shv[q]; v2u w; w.x = pk2(h.x, h.y); w.y = pk2(h.z, h.w); *(v2u*)(hr + 256 * q + 4 * lane) = w; }
                }
            }
        }
        }
        if (u + G < 256) __syncthreads();
    }
}

#ifndef REP_MASK
#define REP_MASK 0
#endif
constexpr int ppl_count() { int n = 0; for (int s = 0; s < 6; ++s) if (s != 3) n += 1 + ((REP_MASK >> s) & 1); return n; }
constexpr unsigned long long seq_pack() { unsigned long long p = 0; int j = 0; for (int s = 0; s < 6; ++s) if (s != 3) for (int r = 0; r < 1 + ((REP_MASK >> s) & 1); ++r) { p |= (unsigned long long)s << (4 * j); ++j; } return p; }
constexpr int PPL = ppl_count();
constexpr unsigned long long SEQ_PACK = seq_pack();
#ifndef P0_REP
#define P0_REP 1
#endif
#ifndef BAR_REP
#define BAR_REP 1
#endif
#ifndef P0C_REP
#define P0C_REP 1
#endif
constexpr int NPRE = 1 + P0_REP + P0C_REP;
constexpr int NPH = NPRE + PPL * DEPTH;
#ifndef PH_MASK
#define PH_MASK 127
#endif
struct Args { const float* in[18]; float* out; unsigned char* ws; int ph_lo, ph_hi; };
__global__ void __launch_bounds__(NWAVES * 64, 2) trunk_fwd(Args args) {
    extern __shared__ __attribute__((aligned(16))) unsigned char lds_raw[];
    LAS unsigned char* lds = (LAS unsigned char*)lds_raw;
    const int tid0 = threadIdx.x;
    const int G = gridDim.x, bid0 = blockIdx.x;
    volatile LAS unsigned* MISC = (volatile LAS unsigned*)(lds + MISC_OFF);
    for (int u = tid0; u < (LDS_BYTES - MISC_OFF) / 4; u += NWAVES * 64) ((LAS unsigned*)(lds + MISC_OFF))[u] = 0u;
    __syncthreads();
    const int lo = args.ph_lo, hi_ph = args.ph_hi;
    XcdBarrier bar; bar.bar = (unsigned*)(args.ws + WS_CTL) + CW_BAR; bar.x = 0; bar.st = nullptr;
    if (hi_ph - lo > 1) bar = xcd_barrier_post((unsigned*)(args.ws + WS_CTL) + CW_BAR, MISC + 8);

    for (int ph = lo; ph < hi_ph; ++ph) {
        int tid = tid0; asm volatile("" : "+v"(tid));
#define RELAUNDER() do { asm volatile("" : "+v"(tid)); } while (0)
        int bid = bid0; asm volatile("" : "+s"(bid));
        size_t wsoff = 0; asm volatile("" : "+s"(wsoff)); unsigned char* ws = args.ws + wsoff;
        const int vcu = (G % 8 == 0) ? (bid % 8) * (G / 8) + bid / 8 : bid;
        float* MOD = (float*)(ws + WS_MOD);
        bf16* WIN = (bf16*)(ws + WS_WIN); bf16* WOUT = (bf16*)(ws + WS_WOUT); bf16* WQ = (bf16*)(ws + WS_WQ); bf16* POOLW = (bf16*)(ws + WS_POOLW); bf16* SUBK = (bf16*)(ws + WS_SUBK);
        bf16* H = (bf16*)(ws + WS_H); bf16* PROJ = (bf16*)(ws + WS_PROJ); bf16* Y = (bf16*)(ws + WS_Y); bf16* QP = (bf16*)(ws + WS_QP);
        float* GG2 = (float*)(ws + WS_GG2); float* SHQ = (float*)(ws + WS_SHQ); float* SS = (float*)(ws + WS_SS);
        unsigned char* U8 = ws + WS_U8; unsigned char* V8 = ws + WS_V8; float* SU = (float*)(ws + WS_SU); float* SV = (float*)(ws + WS_SV);
        float* X = args.out;
        const int NGW = G * NWAVES;
#define LANE_WAVE() RELAUNDER(); const int lane = tid & 63, wave = __builtin_amdgcn_readfirstlane(tid >> 6); const int gw = vcu * NWAVES + wave; (void)lane; (void)gw
        if (ph == 0) {
            RELAUNDER();
            phase_modp(lds, args.in[1], args.in[2], (float*)(ws + WS_PROJ), tid, bid, G);
        } else if (ph < 1 + P0_REP && (PH_MASK & 1)) {
            LANE_WAVE();
            mod_reduce((const float*)(ws + WS_PROJ), args.in[3], MOD, (size_t)bid * 512 + tid, (size_t)G * 512);
            {
                constexpr int T_IN = 16 * 10, T_OUT = 16 * 8, T_WQ = 16 * 16, T_L = T_IN + T_OUT + T_WQ, T_POOL = 32;
                LAS float* tile = (LAS float*)lds;
                __syncthreads();
                for (int it = bid; it < DEPTH * T_L + T_POOL; it += G) {
                    if (it < DEPTH * T_L) {
                        const int l = it / T_L; const int r = it - l * T_L;
                        if (r < T_IN) p0_transpose_tile(args.in[6] + (size_t)l * DM * INW, DM, INW, WIN + (size_t)l * INW * DM, tile, r, tid);
                        else if (r < T_IN + T_OUT) p0_transpose_tile(args.in[13] + (size_t)l * DM * DM, DM, DM, WOUT + (size_t)l * DM * DM, tile, r - T_IN, tid);
                        else p0_transpose_tile(args.in[14] + (size_t)l * DM * 2048, DM, 2048, WQ + (size_t)l * 2048 * DM, tile, r - T_IN - T_OUT, tid);
                    } else {
                        const int r = it - DEPTH * T_L, lg = r >> 1;
                        p0_transpose_tile(args.in[7] + (size_t)lg * 128 * 128, 128, 128, POOLW + (size_t)lg * 128 * 128, tile, r & 1, tid);
                    }
                }
            }
            const size_t gt = (size_t)bid * 512 + tid, GT = (size_t)G * 512;
            cvt_stream(args.in[15], SUBK, (size_t)DEPTH * 2 * 128 * 128 / 8, gt, GT);
            quant_rows<0>(args.in[16], U8, SU, 0, NEXP, gw, NGW, lane);
            quant_rows<0>(args.in[17], V8, SU + 1, 0, NEXP, gw, NGW, lane);
            if (G != 256) { quant_rows<0>(args.in[16], U8, SU, NEXP, DEPTH * NEXP, gw, NGW, lane); quant_rows<0>(args.in[17], V8, SU + 1, NEXP, DEPTH * NEXP, gw, NGW, lane); }
        } else if (ph < NPRE && (PH_MASK & 2)) {
            LANE_WAVE();
            norm_rows_phase(args.in[0], args.in[4], MOD, 0, 1024, H, gw, NGW, lane);
            for (int i = bid * 512 + tid; i < DEPTH * 8 * DM; i += G * 512) { const int k = i & (DM - 1), lb = i >> 10; GG2[i] = args.in[5][(lb >> 3) * DM + k] * (1.f + MOD[(size_t)lb * NMOD + 4096 + k]); }
            for (int it = gw; it < DEPTH * 512; it += NGW) {
                const int l = it >> 9, nb = (it & 511) * 4;
                int lane_q = lane; asm volatile("" : "+v"(lane_q));
                v4u wr[4][2];
#pragma unroll
                for (int i = 0; i < 4; ++i) { const bf16* wr_ = WQ + ((size_t)l * 2048 + nb + i) * DM + 16 * lane_q; wr[i][0] = *(const v4u*)wr_; wr[i][1] = *(const v4u*)(wr_ + 8); }
#pragma unroll 1
                for (int hb = 0; hb < 8; hb += 4) {
                    f32x4 shv[4][4];
#pragma unroll
                    for (int b = 0; b < 4; ++b)
#pragma unroll
                        for (int q4 = 0; q4 < 4; ++q4) shv[b][q4] = *(const f32x4*)(MOD + ((size_t)l * 8 + hb + b) * NMOD + 3072 + 16 * lane_q + 4 * q4);
#pragma unroll
                    for (int i = 0; i < 4; ++i) {
                        float wf[16]; { float f8[8]; unpack8(wr[i][0], f8);
#pragma unroll
                            for (int k = 0; k < 8; ++k) wf[k] = f8[k];
                            unpack8(wr[i][1], f8);
#pragma unroll
                            for (int k = 0; k < 8; ++k) wf[8 + k] = f8[k]; }
#pragma unroll
                        for (int b = 0; b < 4; ++b) { float s = 0.f;
#pragma unroll
                            for (int q4 = 0; q4 < 4; ++q4) { const f32x4 sv = shv[b][q4]; s += (sv.x * wf[4 * q4] + sv.y * wf[4 * q4 + 1]) + (sv.z * wf[4 * q4 + 2] + sv.w * wf[4 * q4 + 3]); }
                            s = wave_sum(s); if (lane == 0) SHQ[((size_t)l * 8 + hb + b) * 2048 + nb + i] = s; }
                    }
                }
            }
        } else {
            const int l = (ph - NPRE) / PPL, sub = (int)((SEQ_PACK >> (4 * ((ph - NPRE) - PPL * l))) & 15ull);
            const float* modl = MOD + (size_t)l * 8 * NMOD;
            const int jn = (ph - NPRE) - PPL * l + 1; const float peer_scale = (jn < PPL && (int)((SEQ_PACK >> (4 * jn)) & 15ull) == 5) ? 0.f : 1.f;
            const float gemm2_scale = (sub == 2 && jn < PPL && (int)((SEQ_PACK >> (4 * jn)) & 15ull) == 2) ? 0.f : 1.f;
            if (sub == 0 && (PH_MASK & 4)) {
                RELAUNDER();
                pg8::Gemm g{H, WIN + (size_t)l * INW * DM, T, INW, DM}; pg8::StaticOrder S; S.init(T, INW, G, bid);
                pg8::EpiBf16<0> E{PROJ, INW, nullptr, 0, 0, 1.f};
                pg8::gemm_phase<pg8::EpiBf16<0>, pg8::StaticOrder, true, true>(lds, g, S, E, tid);
                if (G == 256 && bid >= 64 && l + 1 < DEPTH) {
                    const int wave2 = __builtin_amdgcn_readfirstlane(tid >> 6), gw2 = (bid - 64) * NWAVES + wave2, NGW2 = (G - 64) * NWAVES;
                    quant_rows<0>(args.in[16], U8, SU, (l + 1) * NEXP, (l + 2) * NEXP, gw2, NGW2, tid & 63);
                    quant_rows<0>(args.in[17], V8, SU + 1, (l + 1) * NEXP, (l + 2) * NEXP, gw2, NGW2, tid & 63);
                }
            } else if (sub == 4 && (PH_MASK & 4)) {
                RELAUNDER();
                pg8::Gemm g{H, WQ + (size_t)l * 2048 * DM, T, 2048, DM}; pg8::StaticOrder S; S.init(T, 2048, G, bid);
                pg8::EpiBf16RS E{QP, 2048, SS, SHQ + (size_t)l * 8 * 2048};
                pg8::gemm_phase<pg8::EpiBf16RS, pg8::StaticOrder, true, true>(lds, g, S, E, tid);
            } else if (sub == 1 && (PH_MASK & 8)) {
                RELAUNDER();
                phase_mix(lds, PROJ, POOLW + (size_t)l * 4 * 128 * 128, args.in[8] + l * 512, args.in[9] + l * 64, args.in[10] + l * 64, args.in[11] + l * 8, args.in[12] + l * DM, Y, tid, vcu, G);
            } else if (sub == 2 && (PH_MASK & 16)) {
                RELAUNDER();
                pg8::Gemm g{Y, WOUT + (size_t)l * DM * DM, T, DM, DM}; pg8::StaticOrder S; S.init(T, DM, G, bid);
                if (G == 256) { pg8::EpiRes2 E{l == 0 ? args.in[0] : X, X, modl + 2048, GG2 + (size_t)l * 8 * DM, H, SS, gemm2_scale};
                    pg8::gemm_phase<pg8::EpiRes2, pg8::StaticOrder, false, true>(lds, g, S, E, tid); }
            } else if (sub == 3 && (PH_MASK & 32)) {
                LANE_WAVE();
                norm_rows_phase(X, args.in[5] + l * DM, modl, 3072, 4096, H, gw, NGW, lane);
            } else if (PH_MASK & 64) {
                RELAUNDER();
                phase_peer(lds, QP, SUBK + (size_t)l * 2 * 128 * 128, U8 + (size_t)l * NEXP * DM, V8 + (size_t)l * NEXP * DM, SU + (size_t)l * NEXP * 2, SV, X, modl, args.in[5] + l * DM,
                           (l + 1 < DEPTH) ? args.in[4] + (l + 1) * DM : nullptr, MOD + (size_t)(l + 1 < DEPTH ? l + 1 : l) * 8 * NMOD, H, tid, bid, G, peer_scale);
            }
        }
        if (ph + 1 < hi_ph) { xcd_barrier(bar); for (int br = 1; br < BAR_REP; ++br) xcd_barrier(bar); }
    }
}

extern "C" void kernel_launch(void* const* d_in, const int* in_sizes, int n_in, void* d_out, int out_size, void* d_ws, size_t ws_size, hipStream_t stream) {
    static int grid = 0;
    if (grid == 0) {
        if (n_in != 18 || out_size != T * DM || ws_size < WS_END) { fprintf(stderr, "kernel_launch: unexpected shapes (n_in %d, out %d, ws %zu); nothing launched\n", n_in, out_size, ws_size); grid = -1; return; }
        int dev = 0, cus = 0, per_cu = 0;
        if (hipGetDevice(&dev) != hipSuccess || hipDeviceGetAttribute(&cus, hipDeviceAttributeMultiprocessorCount, dev) != hipSuccess) { fprintf(stderr, "kernel_launch: device query failed\n"); grid = -1; return; }
        if (hipFuncSetAttribute((const void*)trunk_fwd, hipFuncAttributeMaxDynamicSharedMemorySize, LDS_BYTES) != hipSuccess) { fprintf(stderr, "kernel_launch: hipFuncSetAttribute failed\n"); grid = -1; return; }
        if (hipOccupancyMaxActiveBlocksPerMultiprocessor(&per_cu, (const void*)trunk_fwd, NWAVES * 64, LDS_BYTES) != hipSuccess || per_cu < 1)
            fprintf(stderr, "kernel_launch: note: occupancy query reports %d workgroups per CU\n", per_cu);
        (void)hipGetLastError();
        grid = cus;
    }
    if (grid < 0) return;
    if (hipMemsetAsync((char*)d_ws + WS_CTL, 0, CTL_ZERO_BYTES, stream) != hipSuccess) { fprintf(stderr, "kernel_launch: memset failed\n"); return; }
    Args a{};
    for (int i = 0; i < 18; ++i) a.in[i] = (const float*)d_in[i];
    a.out = (float*)d_out; a.ws = (unsigned char*)d_ws;
#if MK_PER_PHASE
    for (int ph = 0; ph < NPH; ++ph) { a.ph_lo = ph; a.ph_hi = ph + 1; hipLaunchKernelGGL(trunk_fwd, dim3(grid), dim3(NWAVES * 64), LDS_BYTES, stream, a); }
#else
    a.ph_lo = 0; a.ph_hi = NPH;
    hipLaunchKernelGGL(trunk_fwd, dim3(grid), dim3(NWAVES * 64), LDS_BYTES, stream, a);
#endif
    const hipError_t le = hipPeekAtLastError();
    if (le != hipSuccess) fprintf(stderr, "kernel_launch: launch failed: %s\n", hipGetErrorName(le));
}
```
